# Optimizing an MI355X kernel written in HIP

```python
import jax, jax.numpy as jnp
from jax import lax
import numpy as np

D_MODEL = 1024
BATCH = 4
SEQ = 8192
DEPTH = 2

HEAD_DIM = 64
N_MLSTM_HEADS = D_MODEL // (2 * HEAD_DIM)
N_SB_HEADS = D_MODEL // (2 * HEAD_DIM)
D_MLSTM = N_MLSTM_HEADS * HEAD_DIM
D_SB = N_SB_HEADS * HEAD_DIM
D_MIX = D_MLSTM + D_SB
D_FF = 4 * D_MODEL
CONV_WIDTH = 4
MLSTM_CHUNK = 64
SB_BLOCK = 128
NORM_EPS = 1e-6
D_IN_PROJ = 4 * D_MLSTM + 2 * N_MLSTM_HEADS + 3 * D_SB

kernel_name = "hymba_mlstm_stickbreaking_trunk"


def _rmsnorm(x, g):
    xf = x.astype(jnp.float32)
    y = xf * lax.rsqrt(jnp.mean(xf * xf, axis=-1, keepdims=True) + NORM_EPS)
    return y * g.astype(jnp.float32)


def _head_rmsnorm(y, g):
    B, S, H, d = y.shape
    return _rmsnorm(y, g.reshape(H, d))


def _causal_depthwise_conv(u, w, b):
    S = u.shape[1]
    up = jnp.pad(u, ((0, 0), (CONV_WIDTH - 1, 0), (0, 0)))
    y = b
    for j in range(CONV_WIDTH):
        y = y + up[:, j:j + S, :] * w[j]
    return y


def _to_heads(a, H):
    B, S, _ = a.shape
    return a.reshape(B, S, H, HEAD_DIM).transpose(0, 2, 1, 3).astype(jnp.float32)


def _mlstm_chunkwise(q, k, v, i_pre, f_pre):
    B, H, S, d = q.shape
    L = MLSTM_CHUNK
    nc = S // L
    q = q * (d ** -0.5)
    logf = jax.nn.log_sigmoid(f_pre)

    def to_chunks(a):
        return jnp.moveaxis(a.reshape(B, H, nc, L, *a.shape[3:]), 2, 0)

    tri = jnp.tril(jnp.ones((L, L), dtype=bool))

    def step(carry, inp):
        C, n, m_prev = carry
        qc, kc, vc, ic, fc = inp
        b = jnp.cumsum(fc, axis=-1)
        Dlog = jnp.where(tri, b[..., :, None] - b[..., None, :] + ic[..., None, :], -jnp.inf)
        m_inter = b + m_prev[..., None]
        m = jnp.maximum(m_inter, jnp.max(Dlog, axis=-1))
        W = jnp.exp(Dlog - m[..., None]) * jnp.einsum('bhtd,bhsd->bhts', qc, kc)
        s_inter = jnp.exp(m_inter - m)
        num = s_inter[..., None] * jnp.einsum('bhtk,bhkv->bhtv', qc, C) + jnp.einsum('bhts,bhsv->bhtv', W, vc)
        den = s_inter * jnp.einsum('bhtk,bhk->bht', qc, n) + jnp.sum(W, axis=-1)
        h = num / jnp.maximum(jnp.abs(den), jnp.exp(-m))[..., None]
        b_last = b[..., -1]
        g = b_last[..., None] - b + ic
        m_new = jnp.maximum(b_last + m_prev, jnp.max(g, axis=-1))
        decay = jnp.exp(b_last + m_prev - m_new)
        w_s = jnp.exp(g - m_new[..., None])
        C_new = decay[..., None, None] * C + jnp.einsum('bhs,bhsk,bhsv->bhkv', w_s, kc, vc)
        n_new = decay[..., None] * n + jnp.einsum('bhs,bhsk->bhk', w_s, kc)
        return (C_new, n_new, m_new), h

    init = (jnp.zeros((B, H, d, d), jnp.float32), jnp.zeros((B, H, d), jnp.float32),
            jnp.zeros((B, H), jnp.float32))
    _, hs = lax.scan(step, init, (to_chunks(q), to_chunks(k), to_chunks(v), to_chunks(i_pre), to_chunks(logf)))
    return jnp.moveaxis(hs, 0, 2).reshape(B, H, S, d)


def _stick_breaking(q, k, v):
    B, H, S, d = q.shape
    scale = d ** -0.5
    outs = []
    for blk in range(S // SB_BLOCK):
        t0 = blk * SB_BLOCK
        t1 = t0 + SB_BLOCK
        qb = q[:, :, t0:t1]
        kb = k[:, :, :t1]
        vb = v[:, :, :t1]
        z = jnp.einsum('bhtd,bhsd->bhts', qb, kb) * scale
        causal = jnp.arange(t1)[None, :] < (t0 + jnp.arange(SB_BLOCK))[:, None]
        log_1m_beta = jnp.where(causal, jax.nn.log_sigmoid(-z), 0.0)
        after = lax.cumsum(log_1m_beta, axis=3, reverse=True) - log_1m_beta
        A = jnp.where(causal, jnp.exp(jax.nn.log_sigmoid(z) + after), 0.0)
        outs.append(jnp.einsum('bhts,bhsv->bhtv', A, vb))
    return jnp.concatenate(outs, axis=2)


def setup_inputs(seed: int = 0) -> dict:
    key = jax.random.key(seed)
    ks = jax.random.split(key, 15)
    f32 = jnp.float32
    x = jax.random.normal(ks[0], (BATCH, SEQ, D_MODEL), f32)
    attn_norm_g = 1.0 + 0.02 * jax.random.normal(ks[1], (DEPTH, D_MODEL), f32)
    w_in = jax.random.normal(ks[2], (DEPTH, D_MODEL, D_IN_PROJ), f32) * D_MODEL ** -0.5
    conv_w = jax.random.normal(ks[3], (DEPTH, CONV_WIDTH, 2 * D_MLSTM), f32) * CONV_WIDTH ** -0.5
    conv_b = 0.02 * jax.random.normal(ks[4], (DEPTH, 2 * D_MLSTM), f32)
    b_igate = 0.1 * jax.random.normal(ks[5], (DEPTH, N_MLSTM_HEADS), f32)
    b_fgate = jnp.linspace(3.0, 6.0, N_MLSTM_HEADS, dtype=f32)[None, :] + 0.1 * jax.random.normal(ks[6], (DEPTH, N_MLSTM_HEADS), f32)
    q_norm_g = 1.0 + 0.02 * jax.random.normal(ks[7], (DEPTH, HEAD_DIM), f32)
    k_norm_g = 1.0 + 0.02 * jax.random.normal(ks[8], (DEPTH, HEAD_DIM), f32)
    out_norm_g = 1.0 + 0.02 * jax.random.normal(ks[9], (DEPTH, D_MIX), f32)
    w_out = jax.random.normal(ks[10], (DEPTH, D_MIX, D_MODEL), f32) * D_MIX ** -0.5
    mlp_norm_g = 1.0 + 0.02 * jax.random.normal(ks[11], (DEPTH, D_MODEL), f32)
    w_up = jax.random.normal(ks[12], (DEPTH, D_MODEL, D_FF), f32) * D_MODEL ** -0.5
    w_down = jax.random.normal(ks[13], (DEPTH, D_FF, D_MODEL), f32) * D_FF ** -0.5
    return {"x": x, "attn_norm_g": attn_norm_g, "w_in": w_in, "conv_w": conv_w, "conv_b": conv_b,
            "b_igate": b_igate, "b_fgate": b_fgate, "q_norm_g": q_norm_g, "k_norm_g": k_norm_g,
            "out_norm_g": out_norm_g, "w_out": w_out, "mlp_norm_g": mlp_norm_g, "w_up": w_up, "w_down": w_down}


def reference(x, attn_norm_g, w_in, conv_w, conv_b, b_igate, b_fgate, q_norm_g, k_norm_g,
              out_norm_g, w_out, mlp_norm_g, w_up, w_down):
    B, S, _ = x.shape
    o_qk, o_v, o_o, o_i, o_f = 0, 2 * D_MLSTM, 3 * D_MLSTM, 4 * D_MLSTM, 4 * D_MLSTM + N_MLSTM_HEADS
    o_sb = 4 * D_MLSTM + 2 * N_MLSTM_HEADS
    for l in range(DEPTH):
        h = _rmsnorm(x, attn_norm_g[l]).astype(x.dtype)
        p = h @ w_in[l]
        qk_m = jax.nn.silu(_causal_depthwise_conv(p[..., o_qk:o_v], conv_w[l], conv_b[l]))
        q_m = _to_heads(qk_m[..., :D_MLSTM], N_MLSTM_HEADS)
        k_m = _to_heads(qk_m[..., D_MLSTM:], N_MLSTM_HEADS)
        v_m = _to_heads(p[..., o_v:o_o], N_MLSTM_HEADS)
        o_gate = jax.nn.sigmoid(p[..., o_o:o_i].astype(jnp.float32))
        i_pre = (p[..., o_i:o_f] + b_igate[l]).astype(jnp.float32).transpose(0, 2, 1)
        f_pre = (p[..., o_f:o_sb] + b_fgate[l]).astype(jnp.float32).transpose(0, 2, 1)
        y_m = _mlstm_chunkwise(q_m, k_m, v_m, i_pre, f_pre).transpose(0, 2, 1, 3)
        y_m = _head_rmsnorm(y_m, out_norm_g[l, :D_MLSTM]).reshape(B, S, D_MLSTM) * o_gate
        q_s = _rmsnorm(_to_heads(p[..., o_sb:o_sb + D_SB], N_SB_HEADS), q_norm_g[l])
        k_s = _rmsnorm(_to_heads(p[..., o_sb + D_SB:o_sb + 2 * D_SB], N_SB_HEADS), k_norm_g[l])
        v_s = _to_heads(p[..., o_sb + 2 * D_SB:], N_SB_HEADS)
        y_s = _stick_breaking(q_s, k_s, v_s).transpose(0, 2, 1, 3)
        y_s = _head_rmsnorm(y_s, out_norm_g[l, D_MLSTM:]).reshape(B, S, D_SB)
        y = jnp.concatenate([y_m, y_s], axis=-1).astype(x.dtype)
        x = x + y @ w_out[l]
        h = _rmsnorm(x, mlp_norm_g[l]).astype(x.dtype)
        x = x + jnp.square(jax.nn.relu(h @ w_up[l])) @ w_down[l]
    return x
```

```cpp
#include <hip/hip_runtime.h>
#include <hip/hip_cooperative_groups.h>
#include <cstdio>
#include <cstdint>
namespace cg = cooperative_groups;
namespace pg8 {
#define PG8_LAS __attribute__((address_space(3)))
typedef unsigned short bf16_t;
typedef short bf16x8 __attribute__((ext_vector_type(8)));
typedef float f32x4 __attribute__((ext_vector_type(4)));
typedef unsigned u32x4 __attribute__((ext_vector_type(4)));
constexpr int BM = 256, BK = 64, HALF = 128, HTB = HALF * BK * 2  , STAGE_BYTES = 8 * HTB, NXCD = 8, WGM = 8;

__host__ __device__ __forceinline__ int lds_byte(int r, int c) { const int st = (r >> 4) * 2 + (c >> 5), rr = r & 15, cc = c & 31, ob = rr * 64 + cc * 2; return st * 1024 + (ob ^ (((ob >> 9) & 1) << 5)); }
__host__ __device__ __forceinline__ void stage_rc(int b, int& R, int& C) { const int st = b / 1024, sb = b % 1024, swz = sb ^ (((sb >> 9) & 1) << 5); R = (st >> 1) * 16 + swz / 64; C = (st & 1) * 32 + (swz % 64) / 2; }
__host__ __device__ __forceinline__ int perm32(int rho) { const int n = rho >> 4, i = rho & 15; return 8 * (i >> 2) + 4 * n + (i & 3); }

struct Unit { int pm, pn; };
struct Gemm { const bf16_t* A; const bf16_t* Bt; int M, N, K; };

struct StaticOrder {
    int nM, nN, nwg, G, c;
    __host__ __device__ void init(int M, int N, int G_, int c_) { nM = M / BM; nN = N / BM; nwg = nM * nN; G = G_; c = c_; }
    __host__ __device__ bool next(int i, Unit& u) const {
        const long L = (long)i * G + c; if (L >= nwg) return false;
        int wgid = (int)L; { const int q = nwg / NXCD, r = nwg % NXCD, xcd = wgid % NXCD, off = wgid / NXCD; wgid = (xcd < r ? xcd * (q + 1) : r * (q + 1) + (xcd - r) * q) + off; }
        const int nig = WGM * nN, gid = wgid / nig, fm = gid * WGM, gsz = (nM - fm) < WGM ? (nM - fm) : WGM;
        u.pm = fm + ((wgid % nig) % gsz); u.pn = (wgid % nig) / gsz; return true;
    }
    __device__ __forceinline__ void a_ready(const Unit&) const {}
    __device__ __forceinline__ void done(const Unit&) const {}
};

__device__ __forceinline__ unsigned cvt_pk_bf16(float lo, float hi) { unsigned r; asm volatile("v_cvt_pk_bf16_f32 %0, %1, %2" : "=v"(r) : "v"(lo), "v"(hi)); return r; }
template <class Epi, class Sched, bool ALIGN_EPI = false, bool SP2 = false>
__device__ __forceinline__ void gemm_phase(PG8_LAS unsigned char* lds, const Gemm g, const Sched& S, const Epi& E, const int tid) {
    const int wid = __builtin_amdgcn_readfirstlane(tid >> 6), lane = tid & 63, wr = wid >> 2, wc = wid & 3, fr = lane & 15, fq = lane >> 4;
    const int K = g.K, nt = K / BK;
    unsigned voffA[2], voffB[2];
#pragma unroll
    for (int i = 0; i < 2; ++i) { int R, C; stage_rc(tid * 16 + i * 8192, R, C); const int Rb = Epi::PERM ? ((R & ~31) + perm32(R & 31)) : R;
        voffA[i] = (unsigned)(R * K + C) * 2u; voffB[i] = (unsigned)(Rb * K + C) * 2u; }
    const size_t kstep = (size_t)(BK * 2);
    const size_t hstep = (size_t)HALF * K * 2;
    const size_t tstep = 2 * hstep;
    const unsigned ldsw = (unsigned)wid * 1024u;
    const int aoff = lds_byte(wr * 64 + fr, fq * 8), boff = lds_byte(wc * 32 + fr, fq * 8);
#define PG8_SA(b, h) (((b) * 2 + (h)) * HTB)
#define PG8_SB(b, h) ((4 + (b) * 2 + (h)) * HTB)
#define PG8_STAGE(bufoff, gbase, voff) do { _Pragma("unroll") for (int _i = 0; _i < 2; ++_i) \
        __builtin_amdgcn_global_load_lds((const unsigned*)((const char*)(gbase) + (voff)[_i]), (PG8_LAS unsigned*)(lds + (bufoff) + ldsw + _i * 8192), 16, 0, 0); } while (0)
#define PG8_LDA(dst, b, h) do { _Pragma("unroll") for (int m = 0; m < 4; ++m) _Pragma("unroll") for (int k = 0; k < 2; ++k) dst[m][k] = *(const PG8_LAS bf16x8*)(lds + PG8_SA(b, h) + aoff + m * 2048 + k * 1024); } while (0)
#define PG8_LDB(dst, b, h) do { _Pragma("unroll") for (int n = 0; n < 2; ++n) _Pragma("unroll") for (int k = 0; k < 2; ++k) dst[n][k] = *(const PG8_LAS bf16x8*)(lds + PG8_SB(b, h) + boff + n * 2048 + k * 1024); } while (0)
#define PG8_MMA(ai, bj, At, Bt) do { __builtin_amdgcn_s_setprio(1); _Pragma("unroll") for (int m = 0; m < 4; ++m) _Pragma("unroll") for (int n = 0; n < 2; ++n) _Pragma("unroll") for (int k = 0; k < 2; ++k) \
        acc[ai][bj][m][n] = __builtin_amdgcn_mfma_f32_16x16x32_bf16(Bt[n][k], At[m][k], acc[ai][bj][m][n], 0, 0, 0); __builtin_amdgcn_s_setprio(0); } while (0)
#define PG8_WAIT_V(n) asm volatile("s_waitcnt vmcnt(" #n ")" ::: "memory")
#define PG8_WAIT_L(n) asm volatile("s_waitcnt lgkmcnt(" #n ")" ::: "memory")
#define PG8_BAR __builtin_amdgcn_s_barrier()
#define PG8_SCHED __builtin_amdgcn_sched_barrier(0)
    Unit cur, nxt; int ui = 0;
    if (!S.next(0, cur)) return;
    f32x4 acc[2][2][4][2];
#pragma unroll
    for (int a = 0; a < 2; ++a)
#pragma unroll
        for (int b = 0; b < 2; ++b)
#pragma unroll
            for (int m = 0; m < 4; ++m)
#pragma unroll
                for (int n = 0; n < 2; ++n) acc[a][b][m][n] = (f32x4){0.f, 0.f, 0.f, 0.f};
    bf16x8 At[4][2], B0[2][2], B1[2][2];
    const char* cA = (const char*)g.A + (size_t)cur.pm * tstep; const char* cB = (const char*)g.Bt + (size_t)cur.pn * tstep;
    S.a_ready(cur);
    if constexpr (SP2) {
        PG8_STAGE(PG8_SB(0, 0), cB, voffB); PG8_STAGE(PG8_SB(0, 1), cB + hstep, voffB); PG8_STAGE(PG8_SA(0, 0), cA, voffA); PG8_STAGE(PG8_SA(0, 1), cA + hstep, voffA);
        if (wr == 1) PG8_BAR;
        PG8_WAIT_V(2); PG8_BAR;
        PG8_STAGE(PG8_SB(1, 0), cB + kstep, voffB); PG8_STAGE(PG8_SA(1, 0), cA + kstep, voffA); PG8_STAGE(PG8_SB(1, 1), cB + hstep + kstep, voffB);
        PG8_WAIT_V(6); PG8_BAR;
    } else {
        PG8_STAGE(PG8_SB(0, 0), cB, voffB); PG8_STAGE(PG8_SA(0, 0), cA, voffA); PG8_STAGE(PG8_SB(0, 1), cB + hstep, voffB); PG8_STAGE(PG8_SA(0, 1), cA + hstep, voffA);
        if (wr == 1) PG8_BAR;
        PG8_WAIT_V(4); PG8_BAR;
        PG8_STAGE(PG8_SB(1, 0), cB + kstep, voffB); PG8_STAGE(PG8_SA(1, 0), cA + kstep, voffA); PG8_STAGE(PG8_SB(1, 1), cB + hstep + kstep, voffB);
        PG8_WAIT_V(6); PG8_BAR;
    }
    for (;;) {
        const bool has_next = S.next(ui + 1, nxt);
        const char* nA = has_next ? (const char*)g.A + (size_t)nxt.pm * tstep : cA; const char* nB = has_next ? (const char*)g.Bt + (size_t)nxt.pn * tstep : cB;
        for (int t = 0; t < nt; t += 2) {
            const bool last = (t == nt - 2);
            const char* a1 = cA + (size_t)(t + 1) * kstep;
            const char* a2 = last ? nA : cA + (size_t)(t + 2) * kstep; const char* b2 = last ? nB : cB + (size_t)(t + 2) * kstep;
            const char* a3 = a2 + kstep; const char* b3 = b2 + kstep;
            if (last && has_next) S.a_ready(nxt);
            if constexpr (SP2) {
            PG8_LDB(B0, 0, 0); PG8_LDB(B1, 0, 1); PG8_SCHED; PG8_LDA(At, 0, 0); PG8_STAGE(PG8_SA(1, 1), a1 + hstep, voffA);
            PG8_WAIT_V(8); PG8_WAIT_L(0); PG8_BAR; PG8_MMA(0, 0, At, B0); PG8_MMA(0, 1, At, B1); PG8_BAR; PG8_SCHED;
            PG8_LDA(At, 0, 1); PG8_STAGE(PG8_SB(0, 0), b2, voffB); PG8_STAGE(PG8_SB(0, 1), b2 + hstep, voffB); PG8_STAGE(PG8_SA(0, 0), a2, voffA);
            PG8_WAIT_V(8); PG8_WAIT_L(0); PG8_BAR; PG8_MMA(1, 0, At, B0); PG8_MMA(1, 1, At, B1); PG8_BAR; PG8_SCHED;
            PG8_LDB(B0, 1, 0); PG8_LDB(B1, 1, 1); PG8_SCHED; PG8_LDA(At, 1, 0); PG8_STAGE(PG8_SA(0, 1), a2 + hstep, voffA);
            PG8_WAIT_V(8); PG8_WAIT_L(0); PG8_BAR; PG8_MMA(0, 0, At, B0); PG8_MMA(0, 1, At, B1); PG8_BAR; PG8_SCHED;
            PG8_LDA(At, 1, 1); PG8_STAGE(PG8_SB(1, 0), b3, voffB); PG8_STAGE(PG8_SB(1, 1), b3 + hstep, voffB); PG8_STAGE(PG8_SA(1, 0), a3, voffA);
            PG8_WAIT_V(8); PG8_WAIT_L(0); PG8_BAR; PG8_MMA(1, 0, At, B0); PG8_MMA(1, 1, At, B1); PG8_BAR; PG8_SCHED;
            } else {
            PG8_LDB(B0, 0, 0); PG8_SCHED; PG8_LDA(At, 0, 0); PG8_STAGE(PG8_SA(1, 1), a1 + hstep, voffA);
            PG8_WAIT_L(8); PG8_BAR; PG8_WAIT_L(0); PG8_MMA(0, 0, At, B0); PG8_BAR; PG8_SCHED;
            PG8_LDB(B1, 0, 1); PG8_STAGE(PG8_SB(0, 0), b2, voffB);
            PG8_BAR; PG8_WAIT_L(0); PG8_MMA(0, 1, At, B1); PG8_BAR;
            PG8_LDA(At, 0, 1); PG8_STAGE(PG8_SA(0, 0), a2, voffA);
            PG8_BAR; PG8_WAIT_L(0); PG8_MMA(1, 0, At, B0); PG8_BAR; PG8_SCHED;
            PG8_STAGE(PG8_SB(0, 1), b2 + hstep, voffB);
            PG8_WAIT_V(6); PG8_BAR; PG8_MMA(1, 1, At, B1); PG8_BAR;
            PG8_LDB(B0, 1, 0); PG8_SCHED; PG8_LDA(At, 1, 0); PG8_STAGE(PG8_SA(0, 1), a2 + hstep, voffA);
            PG8_WAIT_L(8); PG8_BAR; PG8_WAIT_L(0); PG8_MMA(0, 0, At, B0); PG8_BAR; PG8_SCHED;
            PG8_LDB(B1, 1, 1); PG8_STAGE(PG8_SB(1, 0), b3, voffB);
            PG8_BAR; PG8_WAIT_L(0); PG8_MMA(0, 1, At, B1); PG8_BAR;
            PG8_LDA(At, 1, 1); PG8_STAGE(PG8_SA(1, 0), a3, voffA);
            PG8_BAR; PG8_WAIT_L(0); PG8_MMA(1, 0, At, B0); PG8_BAR; PG8_SCHED;
            PG8_STAGE(PG8_SB(1, 1), b3 + hstep, voffB);
            PG8_WAIT_V(6); PG8_BAR; PG8_MMA(1, 1, At, B1); PG8_BAR;
            }
        }
        if constexpr (ALIGN_EPI) { if (wr == 0) PG8_BAR; }
        if constexpr (!Epi::AFTER_DRAIN) { E(acc, cur, wr, wc, fr, fq); S.done(cur); }
        if (!has_next) break;
#pragma unroll
        for (int a = 0; a < 2; ++a)
#pragma unroll
            for (int b = 0; b < 2; ++b)
#pragma unroll
                for (int m = 0; m < 4; ++m)
#pragma unroll
                    for (int n = 0; n < 2; ++n) acc[a][b][m][n] = (f32x4){0.f, 0.f, 0.f, 0.f};
        cur = nxt; cA = nA; cB = nB; ++ui;
        if constexpr (ALIGN_EPI) { if (wr == 1) PG8_BAR; }
    }
    PG8_WAIT_V(0);
    if constexpr (!ALIGN_EPI) { if (wr == 0) PG8_BAR; }
    PG8_BAR;
    if constexpr (Epi::AFTER_DRAIN) { E.fused(acc, cur, wr, wc, fr, fq, lds, wid, lane); S.done(cur); }
#undef PG8_SA
#undef PG8_SB
#undef PG8_STAGE
#undef PG8_LDA
#undef PG8_LDB
#undef PG8_MMA
#undef PG8_WAIT_V
#undef PG8_WAIT_L
#undef PG8_BAR
#undef PG8_SCHED
}
}
#ifndef REP_MASK
#define REP_MASK 0
#endif
#ifndef REP_N
#define REP_N 3
#endif
#ifndef SYNC_N
#define SYNC_N 1
#endif
#ifndef PG8_SP2
#define PG8_SP2 true
#endif
#ifndef PG8_ALIGN
#define PG8_ALIGN true
#endif
#define LAS __attribute__((address_space(3)))
typedef unsigned short bf16;
typedef short bf16x8 __attribute__((ext_vector_type(8)));
typedef short s16x4 __attribute__((ext_vector_type(4)));
typedef float f32x4 __attribute__((ext_vector_type(4)));
typedef float f32x16 __attribute__((ext_vector_type(16)));
typedef unsigned u32x4 __attribute__((ext_vector_type(4)));
typedef unsigned u32x2 __attribute__((ext_vector_type(2)));

constexpr int BATCH = 4, SEQ = 8192, DM = 1024, DEPTH = 2, NHD = 8, DFF = 4096;
constexpr int M = BATCH * SEQ;
constexpr int NIN = 3584, LDP = 3584;
constexpr int NCH = SEQ / 64;
constexpr float EPS = 1e-6f;
constexpr int PC_MQ = 0, PC_MK = 512, PC_MV = 1024, PC_MO = 1536, PC_SQ = 2048, PC_SK = 2560, PC_SV = 3072;
constexpr size_t MiB = 1u << 20;
constexpr size_t WS_SSQ = 0, WS_SC = 512 * 1024, WS_W = 1 * MiB, W_LAYER = 25 * MiB + MiB / 2;
constexpr size_t WO_IN = 0, WO_OUT = 7 * MiB + MiB / 2, WO_UP = 9 * MiB + MiB / 2, WO_DN = 17 * MiB + MiB / 2;
constexpr size_t WS_XB = 52 * MiB, WS_Y = 116 * MiB, WS_P = 180 * MiB, WS_CST = 408 * MiB, WS_H = 180 * MiB, WS_GATE = 473 * MiB, WS_END = 475 * MiB;
constexpr size_t WO_G = 7 * MiB;
constexpr int CST_STRIDE = 4096;
constexpr size_t WS_NST = WS_CST + 40 * MiB;
constexpr int WAVE_LDS = 19712, LDS_BAR_OFF = 8 * WAVE_LDS, LDS_BYTES = LDS_BAR_OFF + 64;
constexpr size_t WS_BAR = 576 * 1024;
constexpr int RS = 144;
static_assert(LDS_BYTES >= pg8::STAGE_BYTES, "lds");

__device__ __forceinline__ float bf2f(unsigned short x) { return __uint_as_float((unsigned)x << 16); }
typedef float f32x2_t __attribute__((ext_vector_type(2))); typedef __bf16 bf16x2_t __attribute__((ext_vector_type(2)));
__device__ __forceinline__ unsigned pk2v(float lo, float hi) { const f32x2_t v = {lo, hi}; const bf16x2_t r = __builtin_convertvector(v, bf16x2_t); return __builtin_bit_cast(unsigned, r); }
__device__ __forceinline__ unsigned pk2(float lo, float hi) { return pg8::cvt_pk_bf16(lo, hi); }
typedef short v4i16_t __attribute__((ext_vector_type(4)));
__device__ __forceinline__ s16x4 tr4(LAS const unsigned char* p) { return __builtin_bit_cast(s16x4, __builtin_amdgcn_ds_read_tr16_b64_v4i16((LAS v4i16_t*)p)); }
__device__ __forceinline__ bf16x8 trfrag16(LAS const unsigned char* T, int rb_lo, int rb_hi, int col, int lane) {
    const int q4 = (lane & 15) >> 2, p = lane & 3;
    const s16x4 lo = tr4(T + (rb_lo + q4) * RS + (col + 4 * p) * 2), hi = tr4(T + (rb_hi + q4) * RS + (col + 4 * p) * 2);
    return (bf16x8){lo[0], lo[1], lo[2], lo[3], hi[0], hi[1], hi[2], hi[3]};
}
__device__ __forceinline__ bf16x8 trfrag32(LAS const unsigned char* T, int rb_lo, int rb_hi, int col32, int lane) {
    const int q4 = (lane & 15) >> 2, p = lane & 3, blk = (lane >> 4) & 1;
    const s16x4 lo = tr4(T + (rb_lo + q4) * RS + (col32 + 16 * blk + 4 * p) * 2), hi = tr4(T + (rb_hi + q4) * RS + (col32 + 16 * blk + 4 * p) * 2);
    return (bf16x8){lo[0], lo[1], lo[2], lo[3], hi[0], hi[1], hi[2], hi[3]};
}
__device__ __forceinline__ float wave_incl_sum(float v, int lane) {
#pragma unroll
    for (int o = 1; o < 64; o <<= 1) { const float t = __shfl_up(v, o); if (lane >= o) v += t; }
    return v;
}
__device__ __forceinline__ float wave_incl_max(float v, int lane) {
#pragma unroll
    for (int o = 1; o < 64; o <<= 1) { const float t = __shfl_up(v, o); if (lane >= o) v = fmaxf(v, t); }
    return v;
}
__device__ __forceinline__ float wave_max(float v) {
#pragma unroll
    for (int o = 1; o < 64; o <<= 1) v = fmaxf(v, __shfl_xor(v, o));
    return v;
}
__device__ __forceinline__ float wave_sum(float v) {
#pragma unroll
    for (int o = 1; o < 64; o <<= 1) v += __shfl_xor(v, o);
    return v;
}

struct EpiP {
    static constexpr bool PERM = true, AFTER_DRAIN = false;
    bf16* O; const float* ssq;
    __device__ __forceinline__ void operator()(const pg8::f32x4 (&acc)[2][2][4][2], const pg8::Unit& u, int wr, int wc, int fr, int fq) const {
        const int row0 = u.pm * 256 + wr * 64 + fr, col0 = u.pn * 256 + wc * 32 + 8 * fq;
        float rr[2][4];
#pragma unroll
        for (int ai = 0; ai < 2; ++ai)
#pragma unroll
            for (int m = 0; m < 4; ++m) rr[ai][m] = ssq[row0 + ai * 128 + m * 16];
#pragma unroll
        for (int ai = 0; ai < 2; ++ai)
#pragma unroll
            for (int m = 0; m < 4; ++m) {
                const int row = row0 + ai * 128 + m * 16; const float r = rsqrtf(rr[ai][m] * (1.0f / DM) + EPS);
                bf16* rowp = O + (size_t)row * LDP + col0;
#pragma unroll
                for (int bj = 0; bj < 2; ++bj) {
                    const pg8::f32x4 v0 = acc[ai][bj][m][0] * r, v1 = acc[ai][bj][m][1] * r;
                    u32x4 w; w.x = pk2(v0[0], v0[1]); w.y = pk2(v0[2], v0[3]); w.z = pk2(v1[0], v1[1]); w.w = pk2(v1[2], v1[3]);
                    *(u32x4*)(rowp + bj * 128) = w; }
            }
    }
};
struct EpiUp {
    static constexpr bool PERM = true, AFTER_DRAIN = false;
    bf16* O; const float* ssq;
    __device__ __forceinline__ void operator()(const pg8::f32x4 (&acc)[2][2][4][2], const pg8::Unit& u, int wr, int wc, int fr, int fq) const {
        const int row0 = u.pm * 256 + wr * 64 + fr, col0 = u.pn * 256 + wc * 32 + 8 * fq;
        float rr[2][4];
#pragma unroll
        for (int ai = 0; ai < 2; ++ai)
#pragma unroll
            for (int m = 0; m < 4; ++m) rr[ai][m] = ssq[row0 + ai * 128 + m * 16];
#pragma unroll
        for (int ai = 0; ai < 2; ++ai)
#pragma unroll
            for (int m = 0; m < 4; ++m) {
                const int row = row0 + ai * 128 + m * 16; const float r = rsqrtf(rr[ai][m] * (1.0f / DM) + EPS);
                bf16* rowp = O + (size_t)row * DFF + col0;
#pragma unroll
                for (int bj = 0; bj < 2; ++bj) {
                    pg8::f32x4 v0 = acc[ai][bj][m][0] * r, v1 = acc[ai][bj][m][1] * r;
#pragma unroll
                    for (int e = 0; e < 4; ++e) { v0[e] = fmaxf(v0[e], 0.f); v0[e] *= v0[e]; v1[e] = fmaxf(v1[e], 0.f); v1[e] *= v1[e]; }
                    u32x4 w; w.x = pk2(v0[0], v0[1]); w.y = pk2(v0[2], v0[3]); w.z = pk2(v1[0], v1[1]); w.w = pk2(v1[2], v1[3]);
                    *(u32x4*)(rowp + bj * 128) = w; }
            }
    }
};
struct EpiRes {
    static constexpr bool PERM = true, AFTER_DRAIN = false;
    const float* base32; bf16* xb; float* out32; float* ssq;
    __device__ __forceinline__ void operator()(const pg8::f32x4 (&acc)[2][2][4][2], const pg8::Unit& u, int wr, int wc, int fr, int fq) const {
        const int row0 = u.pm * 256 + wr * 64 + fr, col0 = u.pn * 256 + wc * 32 + 8 * fq;
#pragma unroll
        for (int ai = 0; ai < 2; ++ai) {
            pg8::f32x4 bv[4][2][2];
#pragma unroll
            for (int m = 0; m < 4; ++m) { const size_t off = (size_t)(row0 + ai * 128 + m * 16) * DM + col0;
                if (base32) {
#pragma unroll
                    for (int bj = 0; bj < 2; ++bj)
#pragma unroll
                        for (int n = 0; n < 2; ++n) bv[m][bj][n] = *(const pg8::f32x4*)(base32 + off + bj * 128 + n * 4);
                } else {
#pragma unroll
                    for (int bj = 0; bj < 2; ++bj) { const u32x4 w = *(const u32x4*)(xb + off + bj * 128);
                        bv[m][bj][0] = (pg8::f32x4){__uint_as_float(w.x << 16), __uint_as_float(w.x & 0xffff0000u), __uint_as_float(w.y << 16), __uint_as_float(w.y & 0xffff0000u)};
                        bv[m][bj][1] = (pg8::f32x4){__uint_as_float(w.z << 16), __uint_as_float(w.z & 0xffff0000u), __uint_as_float(w.w << 16), __uint_as_float(w.w & 0xffff0000u)}; }
                } }
            asm volatile("" ::: "memory");
#pragma unroll
            for (int m = 0; m < 4; ++m) {
                const int row = row0 + ai * 128 + m * 16; const size_t off = (size_t)row * DM + col0; float s = 0.f;
#pragma unroll
                for (int bj = 0; bj < 2; ++bj) {
                    const size_t o2 = off + bj * 128;
                    const pg8::f32x4 o0 = bv[m][bj][0] + acc[ai][bj][m][0], o1 = bv[m][bj][1] + acc[ai][bj][m][1];
                    s += ((o0[0] * o0[0] + o0[1] * o0[1]) + (o0[2] * o0[2] + o0[3] * o0[3])) + ((o1[0] * o1[0] + o1[1] * o1[1]) + (o1[2] * o1[2] + o1[3] * o1[3]));
                    if (out32) { *(pg8::f32x4*)(out32 + o2) = o0; *(pg8::f32x4*)(out32 + o2 + 4) = o1; }
                    else { u32x4 w; w.x = pk2(o0[0], o0[1]); w.y = pk2(o0[2], o0[3]); w.z = pk2(o1[0], o1[1]); w.w = pk2(o1[2], o1[3]); *(u32x4*)(xb + o2) = w; }
                }
                if (ssq) { s += __shfl_xor(s, 16); s += __shfl_xor(s, 32); if (fq == 0) atomicAdd(ssq + row, s); }
            }
        }
    }
};

struct Ctx {
    const float *x, *attn_g, *w_in, *conv_w, *conv_b, *b_i, *b_f, *qn_g, *kn_g, *on_g, *w_out, *mlp_g, *w_up, *w_dn;
    float* out; unsigned char* ws;
    float* ssq; float* sc; bf16 *XB, *Y, *P, *H; bf16* CST; float* NST; float* GATES;
    int G, wg, wave, lane, tid;
};

__device__ __forceinline__ int in_src(int n) { return n < 2048 ? n : n + 16; }
template <bool REMAP>
__device__ __forceinline__ void tr_item(const float* W, int K, int Nsrc, int Ndst, bf16* WT, const float* g, LAS float* scr, int item, int lane) {
    const int nblk = Ndst / 32, kb = item / nblk, nb = item % nblk, k0 = 64 * kb, n0 = 32 * nb;
    const int n = n0 + (lane & 31); const int src = REMAP ? in_src(n) : n;
    float vv[32];
#pragma unroll
    for (int i = 0; i < 32; ++i) { const int kk = 2 * i + (lane >> 5); vv[i] = (src >= 0) ? W[(size_t)(k0 + kk) * Nsrc + src] : 0.f; }
#pragma unroll
    for (int i = 0; i < 32; ++i) { const int kk = 2 * i + (lane >> 5); float v = vv[i]; if (g) v *= g[k0 + kk]; scr[kk * 33 + (lane & 31)] = v; }
    const int c = lane & 7;
#pragma unroll
    for (int j = 0; j < 4; ++j) { const int nn = (lane >> 3) + 8 * j; const LAS float* s = scr + (8 * c) * 33 + nn;
        u32x4 o; o.x = pk2(s[0 * 33], s[1 * 33]); o.y = pk2(s[2 * 33], s[3 * 33]); o.z = pk2(s[4 * 33], s[5 * 33]); o.w = pk2(s[6 * 33], s[7 * 33]);
        *(u32x4*)(WT + (size_t)(n0 + nn) * K + k0 + 8 * c) = o; }
}
__device__ __forceinline__ void weight_items(const Ctx& X, LAS unsigned char* wl, int l, int gwi, int ngwi) {
    LAS float* scr = (LAS float*)wl; const int lane = X.lane;
    constexpr int I_IN = 16 * (NIN / 32), I_OUT = 16 * 32, I_UP = 16 * (DFF / 32), I_DN = 64 * 32, I_L = I_IN + I_OUT + I_UP + I_DN;
    unsigned char* wb = X.ws + WS_W + (size_t)l * W_LAYER;
    for (int it = gwi; it < I_L; it += ngwi) {
        int r = it;
        if (r < I_IN) { tr_item<true>(X.w_in + (size_t)l * DM * 3600, DM, 3600, NIN, (bf16*)(wb + WO_IN), X.attn_g + l * DM, scr, r, lane); continue; } r -= I_IN;
        if (r < I_OUT) { tr_item<false>(X.w_out + (size_t)l * DM * DM, DM, DM, DM, (bf16*)(wb + WO_OUT), nullptr, scr, r, lane); continue; } r -= I_OUT;
        if (r < I_UP) { tr_item<false>(X.w_up + (size_t)l * DM * DFF, DM, DFF, DFF, (bf16*)(wb + WO_UP), X.mlp_g + l * DM, scr, r, lane); continue; } r -= I_UP;
        tr_item<false>(X.w_dn + (size_t)l * DFF * DM, DFF, DM, DM, (bf16*)(wb + WO_DN), nullptr, scr, r, lane);
    }
}
__device__ __forceinline__ void prologue(const Ctx& X, LAS unsigned char* wl) {
    const int gw = X.wg * 8 + X.wave, NGW = X.G * 8, lane = X.lane;
    weight_items(X, wl, 0, gw, NGW);
    for (int i = gw * 64 + lane; i < DEPTH * 16 * DM; i += NGW * 64) { const int l = i / (16 * DM), n = (i / DM) & 15, k = i & (DM - 1);
        ((bf16*)(X.ws + WS_W + (size_t)l * W_LAYER + WO_G))[n * DM + k] = (bf16)(pk2(X.w_in[((size_t)l * DM + k) * 3600 + 2048 + n] * X.attn_g[l * DM + k], 0.f) & 0xffffu); }
    for (int m0 = gw * 4; m0 < M; m0 += NGW * 4) {
        f32x4 v[4][4];
#pragma unroll
        for (int r = 0; r < 4; ++r)
#pragma unroll
            for (int j = 0; j < 4; ++j) v[r][j] = ((const f32x4*)(X.x + (size_t)(m0 + r) * DM) + lane)[64 * j];
#pragma unroll
        for (int r = 0; r < 4; ++r) { float s = 0.f; unsigned long long* o8 = (unsigned long long*)(X.XB + (size_t)(m0 + r) * DM) + lane;
#pragma unroll
            for (int j = 0; j < 4; ++j) { const f32x4 t = v[r][j]; s += (t[0] * t[0] + t[1] * t[1]) + (t[2] * t[2] + t[3] * t[3]);
                o8[64 * j] = (unsigned long long)pk2(t[0], t[1]) | ((unsigned long long)pk2(t[2], t[3]) << 32); }
            s = wave_sum(s);
            if (lane == 0) { const int m = m0 + r; X.ssq[m] = s; X.ssq[M + m] = 0.f; X.ssq[2 * M + m] = 0.f; X.ssq[3 * M + m] = 0.f; } }
    }
}

__device__ __forceinline__ void gates_rows(const Ctx& X, int l, const float* ssq) {
    const int lane = X.lane, fr = lane & 15, g = lane >> 4, gw = X.wg * 8 + X.wave, NGW = X.G * 8;
    const bf16* Wg = (const bf16*)(X.ws + WS_W + (size_t)l * W_LAYER + WO_G) + (size_t)fr * DM + 8 * g;
    for (int t = gw; t < M / 16; t += NGW) {
        const bf16* A = X.XB + (size_t)(16 * t + fr) * DM + 8 * g;
        f32x4 acc = (f32x4){0.f, 0.f, 0.f, 0.f};
#pragma unroll 8
        for (int ks = 0; ks < 32; ++ks) { const bf16x8 a = *(const bf16x8*)(A + 32 * ks), w = *(const bf16x8*)(Wg + 32 * ks); acc = __builtin_amdgcn_mfma_f32_16x16x32_bf16(w, a, acc, 0, 0, 0); }
        const int row = 16 * t + fr; const float r = rsqrtf(ssq[row] * (1.0f / DM) + EPS);
        acc *= r;
        *(f32x4*)(X.GATES + (size_t)row * 16 + 4 * g) = acc;
    }
}

struct ConvW { float w[4][8]; float b[8]; };
__device__ __forceinline__ void load_convw(ConvW& c, const float* conv_w, const float* conv_b, int ch) {
#pragma unroll
    for (int j = 0; j < 4; ++j) { const f32x4 a = *(const f32x4*)(conv_w + j * 1024 + ch), b = *(const f32x4*)(conv_w + j * 1024 + ch + 4);
        c.w[j][0] = a[0]; c.w[j][1] = a[1]; c.w[j][2] = a[2]; c.w[j][3] = a[3]; c.w[j][4] = b[0]; c.w[j][5] = b[1]; c.w[j][6] = b[2]; c.w[j][7] = b[3]; }
    const f32x4 a = *(const f32x4*)(conv_b + ch), b = *(const f32x4*)(conv_b + ch + 4);
    c.b[0] = a[0]; c.b[1] = a[1]; c.b[2] = a[2]; c.b[3] = a[3]; c.b[4] = b[0]; c.b[5] = b[1]; c.b[6] = b[2]; c.b[7] = b[3];
}
__device__ __forceinline__ void conv_silu8(float (&v)[8], const ConvW& c, const bf16* Pb, int tpos, int pc) {
#pragma unroll
    for (int i = 0; i < 8; ++i) v[i] = c.b[i];
#pragma unroll
    for (int j = 0; j < 4; ++j) { const int tt = tpos - 3 + j;
        if (tt >= 0) { const bf16x8 u = *(const bf16x8*)(Pb + (size_t)tt * LDP + pc);
#pragma unroll
            for (int i = 0; i < 8; ++i) v[i] += bf2f((unsigned short)u[i]) * c.w[j][i]; } }
#pragma unroll
    for (int i = 0; i < 8; ++i) v[i] = v[i] * __builtin_amdgcn_rcpf(1.0f + __expf(-v[i]));
}
__device__ __forceinline__ bf16x8 pack8(const float (&v)[8]) {
    u32x4 w; w.x = pk2(v[0], v[1]); w.y = pk2(v[2], v[3]); w.z = pk2(v[4], v[5]); w.w = pk2(v[6], v[7]); return __builtin_bit_cast(bf16x8, w);
}
__device__ __forceinline__ float log_sigmoid(float x) { return fminf(x, 0.f) - __logf(1.0f + __expf(-fabsf(x))); }
#define MFMA16(a, b, c) __builtin_amdgcn_mfma_f32_16x16x32_bf16((a), (b), (c), 0, 0, 0)
#define MFMA32(a, b, c) __builtin_amdgcn_mfma_f32_32x32x16_bf16((a), (b), (c), 0, 0, 0)

__device__ __forceinline__ void conv_rows8(float (&o)[8], const ConvW& c, const bf16x8 (&raw)[11], int r) {
#pragma unroll
    for (int i = 0; i < 8; ++i) o[i] = c.b[i];
#pragma unroll
    for (int j = 0; j < 4; ++j)
#pragma unroll
        for (int i = 0; i < 8; ++i) o[i] = __builtin_fmaf(bf2f((unsigned short)raw[r + j][i]), c.w[j][i], o[i]);
#pragma unroll
    for (int i = 0; i < 8; ++i) o[i] = o[i] * __builtin_amdgcn_rcpf(1.0f + __expf(-o[i]));
}
__device__ __forceinline__ void mlstm_local(const Ctx& X, int l, int bh, int c, LAS unsigned char* wl) {
    const int lane = X.lane, g = lane >> 4, b = bh >> 3, h = bh & 7, oct = lane & 7, rg = lane >> 3;
    const bf16* Pb = X.P + (size_t)b * SEQ * LDP; const int t0 = c * 64;
    bf16* QKb = (bf16*)X.out + ((size_t)b * SEQ + t0) * DM;
    LAS unsigned char* KW = wl; LAS unsigned char* Vt = wl + 64 * RS; LAS float* wsm = (LAS float*)(wl + 2 * 64 * RS);
    bf16x8 rq[11], rk[11]; u32x4 vv[8];
    const float* grow = X.GATES + ((size_t)b * SEQ + t0 + lane) * 16;
    const float gi = grow[h], gf = grow[8 + h];
#pragma unroll
    for (int i = 0; i < 11; ++i) { const int tt = t0 + 8 * rg - 3 + i;
        if (tt >= 0) { rq[i] = *(const bf16x8*)(Pb + (size_t)tt * LDP + PC_MQ + 64 * h + 8 * oct); rk[i] = *(const bf16x8*)(Pb + (size_t)tt * LDP + PC_MK + 64 * h + 8 * oct); }
        else { rq[i] = (bf16x8){0, 0, 0, 0, 0, 0, 0, 0}; rk[i] = (bf16x8){0, 0, 0, 0, 0, 0, 0, 0}; } }
#pragma unroll
    for (int i = 0; i < 8; ++i) vv[i] = *(const u32x4*)(Pb + (size_t)(t0 + 8 * i + rg) * LDP + PC_MV + 64 * h + oct * 8);
    ConvW cwq; load_convw(cwq, X.conv_w + (size_t)l * 4096, X.conv_b + (size_t)l * 1024, 64 * h + 8 * oct);
    {   const float ip = gi + X.b_i[l * NHD + h], fp = gf + X.b_f[l * NHD + h];
        const float bc = wave_incl_sum(log_sigmoid(fp), lane), a = ip - bc, amax = wave_max(a);
        wsm[lane] = __expf(a - amax);
        const float blast = __shfl(bc, 63);
        if (lane == 0) { float* sc = X.sc + (size_t)(bh * NCH + c) * 4; sc[0] = blast; sc[1] = blast + amax; }
    }
#pragma unroll
    for (int i = 0; i < 8; ++i) *(LAS u32x4*)(Vt + (8 * i + rg) * RS + oct * 16) = vv[i];
    {   const ConvW& cw = cwq;
#pragma unroll
        for (int r = 0; r < 8; ++r) { float o[8]; conv_rows8(o, cw, rq, r);
#pragma unroll
            for (int i = 0; i < 8; ++i) o[i] *= 0.125f;
            *(bf16x8*)(QKb + (size_t)(8 * rg + r) * DM + 64 * h + 8 * oct) = pack8(o); } }
    {   ConvW cw; load_convw(cw, X.conv_w + (size_t)l * 4096, X.conv_b + (size_t)l * 1024, 512 + 64 * h + 8 * oct);
        const f32x4 w0 = *(const LAS f32x4*)(wsm + 8 * rg), w1 = *(const LAS f32x4*)(wsm + 8 * rg + 4);
#pragma unroll
        for (int r = 0; r < 8; ++r) { float o[8]; conv_rows8(o, cw, rk, r);
            *(bf16x8*)(QKb + (size_t)(8 * rg + r) * DM + 512 + 64 * h + 8 * oct) = pack8(o);
            const float w = r < 4 ? w0[r & 3] : w1[r & 3];
#pragma unroll
            for (int i = 0; i < 8; ++i) o[i] *= w;
            *(LAS bf16x8*)(KW + (8 * rg + r) * RS + oct * 16) = pack8(o); } }
    const bf16x8 ones = (lane & 15) == 0 ? (bf16x8){0x3F80, 0x3F80, 0x3F80, 0x3F80, 0x3F80, 0x3F80, 0x3F80, 0x3F80} : (bf16x8){0, 0, 0, 0, 0, 0, 0, 0};
    bf16* cst = X.CST + (size_t)(bh * NCH + c) * CST_STRIDE; float* nst = X.NST + (size_t)(bh * NCH + c) * 64;
#pragma unroll 1
    for (int kt = 0; kt < 4; ++kt) {
        f32x4 acc[5];
#pragma unroll
        for (int i = 0; i < 5; ++i) acc[i] = (f32x4){0.f, 0.f, 0.f, 0.f};
#pragma unroll
        for (int ks = 0; ks < 2; ++ks) {
            const bf16x8 bfr = trfrag16(KW, 32 * ks + 8 * g, 32 * ks + 8 * g + 4, 16 * kt, lane);
#pragma unroll
            for (int vt = 0; vt < 4; ++vt) { const bf16x8 afr = trfrag16(Vt, 32 * ks + 8 * g, 32 * ks + 8 * g + 4, 16 * vt, lane); acc[vt] = MFMA16(afr, bfr, acc[vt]); }
            acc[4] = MFMA16(ones, bfr, acc[4]);
        }
        bf16* dst = cst + (16 * kt + (lane & 15)) * 64;
#pragma unroll
        for (int vt = 0; vt < 4; ++vt) { u32x2 w; w.x = pk2v(acc[vt][0], acc[vt][1]); w.y = pk2v(acc[vt][2], acc[vt][3]); *(u32x2*)(dst + 16 * vt + 4 * g) = w; }
        if (g == 0) nst[16 * kt + (lane & 15)] = acc[4][0];
    }
}

__device__ __forceinline__ void mlstm_scan(const Ctx& X) {
    for (int u = X.wg; u < 32 * 4; u += X.G) {
        const int bh = u >> 2, sl = u & 3; const int e2 = sl * 512 + X.tid; const bool extra = (sl == 0 && X.tid < 64);
        unsigned* base = (unsigned*)(X.CST + (size_t)bh * NCH * CST_STRIDE); float* nbase = X.NST + (size_t)bh * NCH * 64; float* sc = X.sc + (size_t)bh * NCH * 4;
        float m = 0.f, C0 = 0.f, C1 = 0.f, Cn = 0.f;
#pragma unroll 1
        for (int cb = 0; cb < NCH; cb += 16) {
            unsigned cl[16]; float cn[16], bl[16], ml[16];
#pragma unroll
            for (int i = 0; i < 16; ++i) { cl[i] = base[(size_t)(cb + i) * (CST_STRIDE / 2) + e2]; cn[i] = extra ? nbase[(cb + i) * 64 + X.tid] : 0.f; bl[i] = sc[(cb + i) * 4 + 0]; ml[i] = sc[(cb + i) * 4 + 1]; }
#pragma unroll
            for (int i = 0; i < 16; ++i) {
                base[(size_t)(cb + i) * (CST_STRIDE / 2) + e2] = pk2(C0, C1); if (extra) nbase[(cb + i) * 64 + X.tid] = Cn;
                if (e2 == 0) sc[(cb + i) * 4 + 2] = m;
                const float mn = fmaxf(bl[i] + m, ml[i]), dec = __expf(bl[i] + m - mn), wl = __expf(ml[i] - mn);
                C0 = dec * C0 + wl * __uint_as_float(cl[i] << 16); C1 = dec * C1 + wl * __uint_as_float(cl[i] & 0xffff0000u); Cn = dec * Cn + wl * cn[i]; m = mn; }
        }
    }
}

__device__ __forceinline__ void mlstm_out(const Ctx& X, int l, int bh, int c, LAS unsigned char* wl) {
    const int lane = X.lane, g = lane >> 4, fr = lane & 15, b = bh >> 3, h = bh & 7;
    const bf16* Pb = X.P + (size_t)b * SEQ * LDP; const int t0 = c * 64;
    LAS unsigned char* Ct = wl; LAS unsigned char* Vt = wl + 64 * RS;
    LAS float* f_as = (LAS float*)(wl + 2 * 64 * RS); LAS float* f_M = f_as + 64; LAS float* f_si = f_as + 128; LAS float* f_en = f_as + 192;
    LAS unsigned short* nb = (LAS unsigned short*)(f_as + 256);
    const bf16* cst = X.CST + (size_t)(bh * NCH + c) * CST_STRIDE; const float* nst = X.NST + (size_t)(bh * NCH + c) * 64;
    {   const float* grow = X.GATES + ((size_t)b * SEQ + t0 + lane) * 16;
        const float mprev = X.sc[(size_t)(bh * NCH + c) * 4 + 2];
        const float ip = grow[h] + X.b_i[l * NHD + h], fp = grow[8 + h] + X.b_f[l * NHD + h];
        const float bc = wave_incl_sum(log_sigmoid(fp), lane), a = ip - bc;
        const float Mt = fmaxf(mprev, wave_incl_max(a, lane));
        f_as[lane] = a; f_M[lane] = Mt; f_si[lane] = __expf(mprev - Mt); f_en[lane] = __expf(-(bc + Mt));
        nb[lane] = (unsigned short)(pk2(nst[lane], 0.f) & 0xffffu);
    }
#pragma unroll
    for (int i = 0; i < 8; ++i) { const int row = 8 * i + (lane >> 3), ch = lane & 7;
        const u32x4 v = *(const u32x4*)(cst + row * 64 + ch * 8); *(LAS u32x4*)(Ct + row * RS + ch * 16) = v; }
#pragma unroll
    for (int i = 0; i < 8; ++i) { const int row = 8 * i + (lane >> 3), ch = lane & 7;
        const u32x4 v = *(const u32x4*)(Pb + (size_t)(t0 + row) * LDP + PC_MV + 64 * h + ch * 8); *(LAS u32x4*)(Vt + row * RS + ch * 16) = v; }
    bf16x8 qf[4][2], kf[4][2];
    {   const bf16* QKb = (const bf16*)X.out + ((size_t)b * SEQ + t0) * DM + 64 * h + 8 * g;
#pragma unroll
        for (int j = 0; j < 4; ++j)
#pragma unroll
            for (int ks = 0; ks < 2; ++ks) { qf[j][ks] = *(const bf16x8*)(QKb + (size_t)(16 * j + fr) * DM + 32 * ks); kf[j][ks] = *(const bf16x8*)(QKb + (size_t)(16 * j + fr) * DM + 512 + 32 * ks); } }
    const bf16x8 ones = fr == 0 ? (bf16x8){0x3F80, 0x3F80, 0x3F80, 0x3F80, 0x3F80, 0x3F80, 0x3F80, 0x3F80} : (bf16x8){0, 0, 0, 0, 0, 0, 0, 0};
    bf16x8 nfr[2];
#pragma unroll
    for (int ks = 0; ks < 2; ++ks) { const bf16x8 t = *(const LAS bf16x8*)(nb + 32 * ks + 8 * g); nfr[ks] = fr == 0 ? t : (bf16x8){0, 0, 0, 0, 0, 0, 0, 0}; }
    const float* og = X.on_g + (size_t)l * DM + 64 * h;
    u32x2 ogate[4][4]; f32x4 gain[4];
#pragma unroll
    for (int vt = 0; vt < 4; ++vt) { gain[vt] = *(const f32x4*)(og + 16 * vt + 4 * g);
#pragma unroll
        for (int j = 0; j < 4; ++j) ogate[j][vt] = *(const u32x2*)(Pb + (size_t)(t0 + 16 * j + fr) * LDP + PC_MO + 64 * h + 16 * vt + 4 * g); }
#pragma unroll
    for (int j = 0; j < 4; ++j) {
        const int t = 16 * j + fr;
        f32x4 acc[5];
#pragma unroll
        for (int i = 0; i < 5; ++i) acc[i] = (f32x4){0.f, 0.f, 0.f, 0.f};
#pragma unroll
        for (int ks = 0; ks < 2; ++ks) {
#pragma unroll
            for (int vt = 0; vt < 4; ++vt) { const bf16x8 afr = trfrag16(Ct, 32 * ks + 8 * g, 32 * ks + 8 * g + 4, 16 * vt, lane); acc[vt] = MFMA16(afr, qf[j][ks], acc[vt]); }
            acc[4] = MFMA16(nfr[ks], qf[j][ks], acc[4]);
        }
        const float si = f_si[t], Mt = f_M[t];
#pragma unroll
        for (int i = 0; i < 5; ++i) acc[i] *= si;
        f32x4 st[4];
#pragma unroll
        for (int sblk = 0; sblk < 4; ++sblk) {
            st[sblk] = (f32x4){0.f, 0.f, 0.f, 0.f};
            if (sblk <= j) {
                st[sblk] = MFMA16(kf[sblk][0], qf[j][0], st[sblk]); st[sblk] = MFMA16(kf[sblk][1], qf[j][1], st[sblk]);
                const f32x4 av = *(const LAS f32x4*)(f_as + 16 * sblk + 4 * g);
#pragma unroll
                for (int e = 0; e < 4; ++e) { const int s = 16 * sblk + 4 * g + e; const float w = (s <= t) ? __expf(av[e] - Mt) : 0.f; st[sblk][e] *= w; }
            }
        }
#pragma unroll
        for (int u = 0; u < 2; ++u) {
            if (2 * u <= j) {
                u32x4 w; w.x = pk2(st[2 * u][0], st[2 * u][1]); w.y = pk2(st[2 * u][2], st[2 * u][3]); w.z = pk2(st[2 * u + 1][0], st[2 * u + 1][1]); w.w = pk2(st[2 * u + 1][2], st[2 * u + 1][3]);
                const bf16x8 wf = __builtin_bit_cast(bf16x8, w);
#pragma unroll
                for (int vt = 0; vt < 4; ++vt) { const bf16x8 afr = trfrag16(Vt, 32 * u + 4 * g, 32 * u + 16 + 4 * g, 16 * vt, lane); acc[vt] = MFMA16(afr, wf, acc[vt]); }
                acc[4] = MFMA16(ones, wf, acc[4]);
            }
        }
        const float den = __shfl(acc[4][0], fr);
        const float inv = __builtin_amdgcn_rcpf(fmaxf(fabsf(den), f_en[t]));
        float ss = 0.f;
#pragma unroll
        for (int vt = 0; vt < 4; ++vt) { acc[vt] *= inv; ss += (acc[vt][0] * acc[vt][0] + acc[vt][1] * acc[vt][1]) + (acc[vt][2] * acc[vt][2] + acc[vt][3] * acc[vt][3]); }
        ss += __shfl_xor(ss, 16); ss += __shfl_xor(ss, 32);
        const float rn = rsqrtf(ss * (1.0f / 64.0f) + EPS);
        bf16* yrow = X.Y + ((size_t)b * SEQ + t0 + t) * DM + 64 * h;
#pragma unroll
        for (int vt = 0; vt < 4; ++vt) { const int v0 = 16 * vt + 4 * g;
            const u32x2 ob = ogate[j][vt]; const f32x4 gg = gain[vt];
            float o[4] = {__uint_as_float(ob.x << 16), __uint_as_float(ob.x & 0xffff0000u), __uint_as_float(ob.y << 16), __uint_as_float(ob.y & 0xffff0000u)};
            float r[4];
#pragma unroll
            for (int e = 0; e < 4; ++e) r[e] = acc[vt][e] * rn * gg[e] * __builtin_amdgcn_rcpf(1.0f + __expf(-o[e]));
            u32x2 w; w.x = pk2(r[0], r[1]); w.y = pk2(r[2], r[3]); *(u32x2*)(yrow + v0) = w; }
    }
}

__device__ __forceinline__ float half_sum(float v) { const auto rr = __builtin_amdgcn_permlane32_swap(__float_as_uint(v), __float_as_uint(v), false, false); return __uint_as_float(rr[0]) + __uint_as_float(rr[1]); }
__device__ __forceinline__ float half_other(float v, int hi) { const auto rr = __builtin_amdgcn_permlane32_swap(__float_as_uint(v), __float_as_uint(v), false, false); return hi ? __uint_as_float(rr[0]) : __uint_as_float(rr[1]); }
__device__ __forceinline__ void norm_frag(bf16x8 (&f)[4], const bf16x8 (&raw)[4], const float* gain, float scale, int hi) {
    float v[4][8]; float ss = 0.f;
#pragma unroll
    for (int ds = 0; ds < 4; ++ds)
#pragma unroll
        for (int i = 0; i < 8; ++i) { v[ds][i] = bf2f((unsigned short)raw[ds][i]); ss += v[ds][i] * v[ds][i]; }
    ss = half_sum(ss);
    const float r = rsqrtf(ss * (1.0f / 64.0f) + EPS) * scale;
#pragma unroll
    for (int ds = 0; ds < 4; ++ds) { const f32x4 g0 = *(const f32x4*)(gain + 16 * ds + 8 * hi), g1 = *(const f32x4*)(gain + 16 * ds + 8 * hi + 4);
        float w[8];
#pragma unroll
        for (int i = 0; i < 4; ++i) { w[i] = v[ds][i] * r * g0[i]; w[4 + i] = v[ds][4 + i] * r * g1[i]; }
        f[ds] = pack8(w); }
}
__device__ __forceinline__ void knorm_frag(bf16x8 (&f)[4], const bf16x8 (&raw)[4]) {
    float v[4][8]; float ss = 0.f;
#pragma unroll
    for (int ds = 0; ds < 4; ++ds)
#pragma unroll
        for (int i = 0; i < 8; ++i) { v[ds][i] = bf2f((unsigned short)raw[ds][i]); ss = __builtin_fmaf(v[ds][i], v[ds][i], ss); }
    ss = half_sum(ss);
    const float r = rsqrtf(ss * (1.0f / 64.0f) + EPS);
#pragma unroll
    for (int ds = 0; ds < 4; ++ds) { float w[8];
#pragma unroll
        for (int i = 0; i < 8; ++i) w[i] = v[ds][i] * r;
        f[ds] = pack8(w); }
}
constexpr int SB_ROWS = 416, SB_VS_OFF = SB_ROWS * RS, SB_FB_OFF = 2 * SB_ROWS * RS, SB_FB_BYTES = 32 * RS;
constexpr int SB_GQK_OFF = SB_FB_OFF + 8 * SB_FB_BYTES, SB_OG_OFF = SB_GQK_OFF + 256;
static_assert(SB_OG_OFF + 256 <= LDS_BAR_OFF, "SB LDS map");
__device__ __forceinline__ void sb_phase(const Ctx& X, int l, LAS unsigned char* lds) {
    const int lane = X.lane, q = lane & 31, hi = lane >> 5, wave = X.wave, tid = X.tid;
    LAS unsigned char* Ks = lds; LAS unsigned char* Vs = lds + SB_VS_OFF; LAS unsigned char* Vfb = lds + SB_FB_OFF + wave * SB_FB_BYTES;
    const int rsub = tid >> 3, ch = tid & 7;
    bf16x8 skr[7]; u32x4 svr[7];
#define SB_STAGE_LOAD(u_) do { const int bh_ = (u_) >> 5, ub_ = (u_) & 31; const bf16* Pb_ = X.P + (size_t)(bh_ >> 3) * SEQ * LDP + 64 * (bh_ & 7) + ch * 8; \
        _Pragma("unroll") for (int i = 0; i < 7; ++i) { const int srow = rsub + 64 * i, grow = 256 * ub_ - 160 + srow; \
            if (srow < SB_ROWS && grow >= 0) { skr[i] = *(const bf16x8*)(Pb_ + (size_t)grow * LDP + PC_SK); svr[i] = *(const u32x4*)(Pb_ + (size_t)grow * LDP + PC_SV); } \
            else { skr[i] = (bf16x8){0, 0, 0, 0, 0, 0, 0, 0}; svr[i] = (u32x4){0u, 0u, 0u, 0u}; } } } while (0)
    int u = X.wg;
    if (u < 32 * 32) SB_STAGE_LOAD(u);
    for (; u < 32 * 32; u += X.G) {
        const int bh = u >> 5, ub = u & 31, b = bh >> 3, h = bh & 7, qb = 8 * ub + wave;
        const bf16* Pb = X.P + (size_t)b * SEQ * LDP;
        bf16x8 qraw[4];
        {   const bf16* rowp = Pb + (size_t)(32 * qb + q) * LDP + PC_SQ + 64 * h + 8 * hi;
#pragma unroll
            for (int ds = 0; ds < 4; ++ds) qraw[ds] = *(const bf16x8*)(rowp + 16 * ds); }
        float gtab = 0.f;
        if (tid < 64) gtab = X.on_g[(size_t)l * DM + 512 + 64 * h + tid];
        else if (tid < 128) gtab = X.qn_g[l * 64 + tid - 64] * X.kn_g[l * 64 + tid - 64] * (0.125f * 1.4426950408889634f);
#pragma unroll
        for (int i = 0; i < 7; ++i) { const int srow = rsub + 64 * i;
            float v[8]; float ss = 0.f;
#pragma unroll
            for (int e = 0; e < 8; ++e) { v[e] = bf2f((unsigned short)skr[i][e]); ss = __builtin_fmaf(v[e], v[e], ss); }
            ss += __shfl_xor(ss, 1); ss += __shfl_xor(ss, 2); ss += __shfl_xor(ss, 4);
            const float r = rsqrtf(ss * (1.0f / 64.0f) + EPS);
#pragma unroll
            for (int e = 0; e < 8; ++e) v[e] *= r;
            if (srow < SB_ROWS) { *(LAS bf16x8*)(Ks + srow * RS + ch * 16) = pack8(v); *(LAS u32x4*)(Vs + srow * RS + ch * 16) = svr[i]; } }
        if (tid < 64) ((LAS float*)(lds + SB_OG_OFF))[tid] = gtab; else if (tid < 128) ((LAS float*)(lds + SB_GQK_OFF))[tid - 64] = gtab;
        __syncthreads();
        if (u + X.G < 32 * 32) SB_STAGE_LOAD(u + X.G);
        bf16x8 qf[4];
        {   float v[4][8]; float ss = 0.f;
#pragma unroll
            for (int ds = 0; ds < 4; ++ds)
#pragma unroll
                for (int i = 0; i < 8; ++i) { v[ds][i] = bf2f((unsigned short)qraw[ds][i]); ss = __builtin_fmaf(v[ds][i], v[ds][i], ss); }
            ss = half_sum(ss);
            const float r = rsqrtf(ss * (1.0f / 64.0f) + EPS);
            const LAS float* gqk = (const LAS float*)(lds + SB_GQK_OFF) + 8 * hi;
#pragma unroll
            for (int ds = 0; ds < 4; ++ds) { const f32x4 a0 = *(const LAS f32x4*)(gqk + 16 * ds), a1 = *(const LAS f32x4*)(gqk + 16 * ds + 4);
                float w[8];
#pragma unroll
                for (int i = 0; i < 4; ++i) { w[i] = v[ds][i] * r * a0[i]; w[4 + i] = v[ds][4 + i] * r * a1[i]; }
                qf[ds] = pack8(w); } }
        f32x16 o0, o1;
#pragma unroll
        for (int r = 0; r < 16; ++r) { o0[r] = 0.f; o1[r] = 0.f; }
        float Pm = 1.0f;
#define SB_CORE(KF, VT, DIAG) do { \
        f32x16 s; \
        _Pragma("unroll") for (int r = 0; r < 16; ++r) s[r] = 0.f; \
        _Pragma("unroll") for (int ds = 0; ds < 4; ++ds) s = MFMA32(KF[ds], qf[ds], s); \
        const bool diag = (DIAG); \
        float fct[16], bet[16];     \
        _Pragma("unroll") for (int r = 0; r < 16; ++r) { const int key = (r & 3) + 8 * (r >> 2) + 4 * hi; \
            const float e = __builtin_amdgcn_exp2f(s[r]); const float rc = __builtin_amdgcn_rcpf(1.0f + e); const bool msk = diag && key >= q; \
            fct[r] = msk ? 1.0f : rc; bet[r] = msk ? 0.f : e * rc; } \
        float T[4], To[4], Pg[4]; \
        _Pragma("unroll") for (int G = 0; G < 4; ++G) { T[G] = (fct[4 * G] * fct[4 * G + 1]) * (fct[4 * G + 2] * fct[4 * G + 3]); To[G] = half_other(T[G], hi); Pg[G] = T[G] * To[G]; } \
        float later[4]; later[3] = 1.0f; later[2] = Pg[3]; later[1] = Pg[3] * Pg[2]; later[0] = later[1] * Pg[1]; \
        float a[16]; \
        _Pragma("unroll") for (int G = 0; G < 4; ++G) { float run = (Pm * later[G]) * (hi == 0 ? To[G] : 1.0f); \
            _Pragma("unroll") for (int e = 3; e >= 0; --e) { const int r = 4 * G + e; a[r] = bet[r] * run; run *= fct[r]; } } \
        Pm *= later[0] * Pg[0]; \
        bf16x8 pf[2]; \
        _Pragma("unroll") for (int kk = 0; kk < 2; ++kk) { u32x4 w; w.x = pk2(a[8 * kk], a[8 * kk + 1]); w.y = pk2(a[8 * kk + 2], a[8 * kk + 3]); w.z = pk2(a[8 * kk + 4], a[8 * kk + 5]); w.w = pk2(a[8 * kk + 6], a[8 * kk + 7]); pf[kk] = __builtin_bit_cast(bf16x8, w); } \
        _Pragma("unroll") for (int kk = 0; kk < 2; ++kk) { \
            const bf16x8 v0 = trfrag32((VT), 16 * kk + 4 * hi, 16 * kk + 8 + 4 * hi, 0, lane), v1 = trfrag32((VT), 16 * kk + 4 * hi, 16 * kk + 8 + 4 * hi, 32, lane); \
            o0 = MFMA32(v0, pf[kk], o0); o1 = MFMA32(v1, pf[kk], o1); } \
    } while (0)
        bool done = false;
        const int tl_min = (8 * ub - 5 >= 0) ? 0 : 5 - 8 * ub;
        for (int Tl = wave + 5; Tl >= tl_min; --Tl) {
            bf16x8 kf[4];
#pragma unroll
            for (int ds = 0; ds < 4; ++ds) kf[ds] = *(const LAS bf16x8*)(Ks + (32 * Tl + q) * RS + (16 * ds + 8 * hi) * 2);
            SB_CORE(kf, Vs + 32 * Tl * RS, Tl == wave + 5);
            if (__all(Pm < 1.17549435e-38f)) { done = true; break; }
        }
        if (!done && 8 * ub - 6 >= 0) {
            const bf16* kbase = Pb + PC_SK + 64 * h + 8 * hi + (size_t)q * LDP;
            const bf16* vbase = Pb + PC_SV + 64 * h + (lane & 7) * 8 + (size_t)(lane >> 3) * LDP;
            for (int kt = 8 * ub - 6; kt >= 0; --kt) {
                bf16x8 kr[4], kf[4]; u32x4 vr[4];
                const bf16* krow_ = kbase + (size_t)(32 * kt) * LDP; const bf16* vrow_ = vbase + (size_t)(32 * kt) * LDP;
#pragma unroll
                for (int ds = 0; ds < 4; ++ds) kr[ds] = *(const bf16x8*)(krow_ + 16 * ds);
#pragma unroll
                for (int i = 0; i < 4; ++i) vr[i] = *(const u32x4*)(vrow_ + (size_t)(8 * i) * LDP);
                knorm_frag(kf, kr);
#pragma unroll
                for (int i = 0; i < 4; ++i) *(LAS u32x4*)(Vfb + (8 * i + (lane >> 3)) * RS + (lane & 7) * 16) = vr[i];
                SB_CORE(kf, Vfb, false);
                if (__all(Pm < 1.17549435e-38f)) break;
            }
        }
#undef SB_CORE
        {   float ss = 0.f;
#pragma unroll
            for (int r = 0; r < 16; ++r) ss += o0[r] * o0[r] + o1[r] * o1[r];
            ss = half_sum(ss);
            const float rn = rsqrtf(ss * (1.0f / 64.0f) + EPS);
            const LAS float* og = (const LAS float*)(lds + SB_OG_OFF);
#pragma unroll
            for (int G = 0; G < 4; ++G) {
                const int d0 = 8 * G + 4 * hi; const f32x4 g0 = *(const LAS f32x4*)(og + d0), g1 = *(const LAS f32x4*)(og + 32 + d0);
                u32x2 w0, w1;
                w0.x = pk2(o0[4 * G] * rn * g0[0], o0[4 * G + 1] * rn * g0[1]); w0.y = pk2(o0[4 * G + 2] * rn * g0[2], o0[4 * G + 3] * rn * g0[3]);
                w1.x = pk2(o1[4 * G] * rn * g1[0], o1[4 * G + 1] * rn * g1[1]); w1.y = pk2(o1[4 * G + 2] * rn * g1[2], o1[4 * G + 3] * rn * g1[3]);
                *(LAS u32x2*)(Vfb + q * RS + d0 * 2) = w0; *(LAS u32x2*)(Vfb + q * RS + (32 + d0) * 2) = w1; }
            bf16* ybase = X.Y + ((size_t)b * SEQ + 32 * qb) * DM + 512 + 64 * h + (lane & 7) * 8;
#pragma unroll
            for (int i = 0; i < 4; ++i) { const int row = 8 * i + (lane >> 3); const u32x4 v = *(const LAS u32x4*)(Vfb + row * RS + (lane & 7) * 16); *(u32x4*)(ybase + (size_t)row * DM) = v; } }
        __syncthreads();
    }
#undef SB_STAGE_LOAD
}

#define XB_TMO      128
#define XB_XCNT(j)  (256  + 64 * (j))
#define XB_XSUB(j)  (1280 + 64 * (j))
#define XB_XGEN(j)  (2304 + 64 * (j))
#define XB_TOP      3328
#define XB_TOPGEN   3392
#define XCD_BAR_WORDS 3456
#define XB_SPIN_CAP (1u << 18)

__device__ __forceinline__ unsigned xb_ld(unsigned* p)              { return __hip_atomic_load(p, __ATOMIC_RELAXED, __HIP_MEMORY_SCOPE_AGENT); }
__device__ __forceinline__ unsigned xb_add(unsigned* p, unsigned v) { return __hip_atomic_fetch_add(p, v, __ATOMIC_RELAXED, __HIP_MEMORY_SCOPE_AGENT); }
__device__ __forceinline__ unsigned xb_xcc_id() { return (unsigned)__builtin_amdgcn_s_getreg((3 << 11) | 20) & 0xFu; }
#define XB_SPIN(cond, bar) do { unsigned _sp = 0; while (cond) { __builtin_amdgcn_s_sleep(1); \
    if ((++_sp & 255u) == 0u) { if (xb_ld(&(bar)[XB_TMO])) break; if (_sp > XB_SPIN_CAP) { atomicAdd(&(bar)[XB_TMO], 1u); break; } } } } while (0)

struct XcdBarrier {
    unsigned* bar; unsigned x;
    volatile LAS unsigned* st;
};

__device__ __forceinline__ XcdBarrier xcd_barrier_post(unsigned* bar, volatile LAS unsigned* st) {
    XcdBarrier b; b.bar = bar; b.x = xb_xcc_id(); b.st = st;
    if (threadIdx.x == 0) (void)xb_add(&bar[XB_XCNT(b.x)], 1u);
    return b;
}
__device__ __forceinline__ void xcd_barrier_complete(unsigned* bar, unsigned x, unsigned& nloc, unsigned& nx) {
    const unsigned G = gridDim.x * gridDim.y * gridDim.z;
    unsigned sum, cnt, mine, sp = 0u;
    for (;;) {
        sum = 0u; cnt = 0u; mine = 0u;
#pragma unroll
        for (unsigned j = 0; j < 16; ++j) { const unsigned c = xb_ld(&bar[XB_XCNT(j)]); sum += c; cnt += (c > 0u) ? 1u : 0u; mine = (j == x) ? c : mine; }
        if (sum == G) break;
        __builtin_amdgcn_s_sleep(1);
        if ((++sp & 255u) == 0u) { if (xb_ld(&bar[XB_TMO])) break; if (sp > XB_SPIN_CAP) { atomicAdd(&bar[XB_TMO], 1u); break; } }
    }
    nloc = mine > 0u ? mine : 1u; nx = cnt > 0u ? cnt : 1u;
}

__device__ __forceinline__ void xcd_barrier(const XcdBarrier& b) {
    asm volatile("s_waitcnt vmcnt(0)" ::: "memory");
    __syncthreads();
    if (threadIdx.x == 0) {
        unsigned* bar = b.bar;
        __builtin_amdgcn_s_waitcnt(0);
        unsigned nloc = b.st[0], nx = b.st[1];
        if (nloc == 0u) { xcd_barrier_complete(bar, b.x, nloc, nx); b.st[0] = nloc; b.st[1] = nx; }
        const unsigned old = xb_add(&bar[XB_XSUB(b.x)], 1u);
        const unsigned gen = old / nloc;
        if (old + 1u == (gen + 1u) * nloc) {
            __builtin_amdgcn_fence(__ATOMIC_RELEASE, "agent");
            asm volatile("s_waitcnt vmcnt(0)" ::: "memory");
            const unsigned og = xb_add(&bar[XB_TOP], 1u);
            const unsigned tg = og / nx;
            if (og + 1u == (tg + 1u) * nx) xb_add(&bar[XB_TOPGEN], 1u);
            else XB_SPIN(xb_ld(&bar[XB_TOPGEN]) == tg, bar);
            __builtin_amdgcn_fence(__ATOMIC_ACQUIRE, "agent");
            xb_add(&bar[XB_XGEN(b.x)], 1u);
            asm volatile("s_waitcnt vmcnt(0)" ::: "memory");
        } else {
            XB_SPIN(xb_ld(&bar[XB_XGEN(b.x)]) == gen, bar);
            __builtin_amdgcn_fence(__ATOMIC_ACQUIRE, "agent");
            asm volatile("s_waitcnt vmcnt(0)" ::: "memory");
        }
    }
    __syncthreads();
}


struct Args { const float* in[14]; float* out; unsigned char* ws; int ph_lo, ph_hi, coop, pad; };
constexpr int N_PHASES = 1 + 7 * DEPTH;
typedef const __attribute__((address_space(4))) Args* KArgs;
__device__ __forceinline__ void build_ctx(Ctx& X, KArgs ap) {
    X.x = ap->in[0]; X.attn_g = ap->in[1]; X.w_in = ap->in[2]; X.conv_w = ap->in[3]; X.conv_b = ap->in[4]; X.b_i = ap->in[5]; X.b_f = ap->in[6]; X.qn_g = ap->in[7]; X.kn_g = ap->in[8];
    X.on_g = ap->in[9]; X.w_out = ap->in[10]; X.mlp_g = ap->in[11]; X.w_up = ap->in[12]; X.w_dn = ap->in[13];
    X.out = ap->out; unsigned char* ws = ap->ws; X.ws = ws;
    X.ssq = (float*)(ws + WS_SSQ); X.sc = (float*)(ws + WS_SC); X.XB = (bf16*)(ws + WS_XB); X.Y = (bf16*)(ws + WS_Y); X.P = (bf16*)(ws + WS_P); X.H = (bf16*)(ws + WS_H);
    X.CST = (bf16*)(ws + WS_CST); X.NST = (float*)(ws + WS_NST); X.GATES = (float*)(ws + WS_GATE);
    int G = gridDim.x, wg = blockIdx.x, tid = threadIdx.x;
    asm volatile("" : "+s"(G), "+s"(wg), "+v"(tid));
    X.G = G; X.wg = wg; X.tid = tid; X.lane = tid & 63; X.wave = __builtin_amdgcn_readfirstlane(tid >> 6);
}
__global__ void __launch_bounds__(512, 2) mk_fwd(Args a_byvalue) {
    extern __shared__ __attribute__((aligned(16))) unsigned char lds_raw[];
    int ph, ph_hi, coop;
    if (threadIdx.x < 2) ((volatile LAS unsigned*)((LAS unsigned char*)lds_raw + LDS_BAR_OFF))[threadIdx.x] = 0u;
    __syncthreads();
    { KArgs ap0 = (KArgs)__builtin_amdgcn_kernarg_segment_ptr(); if (ap0->coop) (void)xcd_barrier_post((unsigned*)(ap0->ws + WS_BAR), (volatile LAS unsigned*)((LAS unsigned char*)lds_raw + LDS_BAR_OFF)); }
    { KArgs ap = (KArgs)__builtin_amdgcn_kernarg_segment_ptr(); ph = ap->ph_lo; ph_hi = ap->ph_hi; coop = ap->coop; }
    int rep = 0;
#pragma unroll 1
    for (; ph < ph_hi;) {
        KArgs ap = (KArgs)__builtin_amdgcn_kernarg_segment_ptr();
        asm volatile("" : "+s"(ap));
        LAS unsigned char* lds = (LAS unsigned char*)lds_raw;
        Ctx X; build_ctx(X, ap);
        LAS unsigned char* wl = lds + X.wave * WAVE_LDS;
        const int gw = X.wg * 8 + X.wave, NGW = X.G * 8;
        int nrep = 1;
        if (ph == 0) { nrep = ((REP_MASK >> 7) & 1) ? REP_N : 1; prologue(X, wl);
 }
        else {
            const int l = (ph - 1) / 7, sub = (ph - 1) % 7;
            nrep = ((REP_MASK >> sub) & 1) ? REP_N : 1;
            {
            unsigned char* wb = X.ws + WS_W + (size_t)l * W_LAYER;
            if (sub == 0) {
                pg8::Gemm g{X.XB, (const bf16*)(wb + WO_IN), M, NIN, DM}; pg8::StaticOrder S; S.init(M, NIN, X.G, X.wg);
                EpiP E{X.P, X.ssq + (size_t)(2 * l) * M};
                pg8::gemm_phase<EpiP, pg8::StaticOrder, PG8_ALIGN, PG8_SP2>(lds, g, S, E, X.tid);
                gates_rows(X, l, X.ssq + (size_t)(2 * l) * M);
            } else if (sub == 1) {
#pragma unroll 1
                for (int rr = 0; rr < ((REP_MASK & 0x100) ? REP_N : 1); ++rr) for (int it = gw; it < 32 * NCH; it += NGW) mlstm_local(X, l, it / NCH, it % NCH, wl);
                __syncthreads();
#pragma unroll 1
                for (int rr = 0; rr < ((REP_MASK & 0x200) ? REP_N : 1); ++rr) sb_phase(X, l, lds);
            } else if (sub == 2) {
                mlstm_scan(X);
                if (l + 1 < DEPTH && X.wg >= 128) weight_items(X, wl, l + 1, (X.wg - 128) * 8 + X.wave, (X.G - 128) * 8);
            } else if (sub == 3) {
                for (int it = gw; it < 32 * NCH; it += NGW) mlstm_out(X, l, it / NCH, it % NCH, wl);
            } else if (sub == 4) {
                pg8::Gemm g{X.Y, (const bf16*)(wb + WO_OUT), M, DM, DM}; pg8::StaticOrder S; S.init(M, DM, X.G, X.wg);
                EpiRes E{l == 0 ? X.x : nullptr, X.XB, nullptr, X.ssq + (size_t)(2 * l + 1) * M};
                pg8::gemm_phase<EpiRes, pg8::StaticOrder, PG8_ALIGN, PG8_SP2>(lds, g, S, E, X.tid);
            } else if (sub == 5) {
                pg8::Gemm g{X.XB, (const bf16*)(wb + WO_UP), M, DFF, DM}; pg8::StaticOrder S; S.init(M, DFF, X.G, X.wg);
                EpiUp E{X.H, X.ssq + (size_t)(2 * l + 1) * M};
                pg8::gemm_phase<EpiUp, pg8::StaticOrder, PG8_ALIGN, PG8_SP2>(lds, g, S, E, X.tid);
            } else {
                pg8::Gemm g{X.H, (const bf16*)(wb + WO_DN), M, DM, DFF}; pg8::StaticOrder S; S.init(M, DM, X.G, X.wg);
                const bool last = (l == DEPTH - 1);
                EpiRes E{nullptr, X.XB, last ? X.out : nullptr, last ? nullptr : X.ssq + (size_t)(2 * l + 2) * M};
                pg8::gemm_phase<EpiRes, pg8::StaticOrder, PG8_ALIGN, PG8_SP2>(lds, g, S, E, X.tid);
            }
            }
        }
        if (REP_MASK != 0 && ++rep < nrep) { __syncthreads(); continue; }
        rep = 0;
        if (ph + 1 < ph_hi) {
            if (!coop) __syncthreads();
            else if (coop > 1) cg::this_grid().sync();
            else { XcdBarrier xbar; xbar.bar = (unsigned*)(X.ws + WS_BAR); xbar.x = xb_xcc_id(); xbar.st = (volatile LAS unsigned*)(lds + LDS_BAR_OFF); for (int sy = 0; sy < SYNC_N; ++sy) xcd_barrier(xbar); }
        }
        ++ph;
    }
}

#ifndef MK_MULTI
#define MK_MULTI 0
#endif
extern "C" void kernel_launch(void* const* d_in, const int* in_sizes, int n_in, void* d_out, int out_size, void* d_ws, size_t ws_size, hipStream_t stream) {
    static int grid = 0;
    if (grid == 0) {
        if (n_in != 14 || out_size != M * DM || ws_size < WS_END) { fprintf(stderr, "kernel_launch: unexpected shapes (n_in %d out %d ws %zu)\n", n_in, out_size, ws_size); grid = -1; return; }
        int dev = 0, cus = 0, per_cu = 0;
        hipGetDevice(&dev); hipDeviceGetAttribute(&cus, hipDeviceAttributeMultiprocessorCount, dev);
        if (hipFuncSetAttribute((const void*)mk_fwd, hipFuncAttributeMaxDynamicSharedMemorySize, LDS_BYTES) != hipSuccess) { fprintf(stderr, "kernel_launch: hipFuncSetAttribute failed\n"); grid = -1; return; }
        if (hipOccupancyMaxActiveBlocksPerMultiprocessor(&per_cu, (const void*)mk_fwd, 512, LDS_BYTES) != hipSuccess || per_cu < 1) { fprintf(stderr, "kernel_launch: occupancy query says %d\n", per_cu); per_cu = 1; }
        (void)hipGetLastError();
        grid = cus * 1;
        fprintf(stderr, "kernel_launch: grid %d (cus %d, per_cu %d)\n", grid, cus, per_cu);
    }
    if (grid < 0) return;
    Args a{};
    for (int i = 0; i < 14; ++i) a.in[i] = (const float*)d_in[i];
    a.out = (float*)d_out; a.ws = (unsigned char*)d_ws;
#if MK_MULTI
    for (int ph = 0; ph < N_PHASES; ++ph) { a.ph_lo = ph; a.ph_hi = ph + 1; a.coop = 0; hipLaunchKernelGGL(mk_fwd, dim3(grid), dim3(512), LDS_BYTES, stream, a); }
#else
    a.ph_lo = 0; a.ph_hi = N_PHASES; a.coop = 1;
    if (hipMemsetAsync((char*)d_ws + WS_BAR, 0, XCD_BAR_WORDS * 4, stream) != hipSuccess) { fprintf(stderr, "kernel_launch: memset failed\n"); return; }
    void* args[] = {&a};
    hipError_t e = hipLaunchCooperativeKernel((const void*)mk_fwd, dim3(grid), dim3(512), args, LDS_BYTES, stream);
    if (e != hipSuccess) fprintf(stderr, "cooperative launch failed: %s (grid %d)\n", hipGetErrorString(e), grid);
#endif
}
```

```cpp
#include <hip/hip_runtime.h>
#include <hip/hip_cooperative_groups.h>
#include <cstdio>
#include <cstdint>
namespace cg = cooperative_groups;
namespace pg8 {
#define PG8_LAS __attribute__((address_space(3)))
typedef unsigned short bf16_t;
typedef short bf16x8 __attribute__((ext_vector_type(8)));
typedef float f32x4 __attribute__((ext_vector_type(4)));
typedef unsigned u32x4 __attribute__((ext_vector_type(4)));
constexpr int BM = 256, BK = 64, HALF = 128, HTB = HALF * BK * 2  , STAGE_BYTES = 8 * HTB, NXCD = 8, WGM = 8;

__host__ __device__ __forceinline__ int lds_byte(int r, int c) { const int st = (r >> 4) * 2 + (c >> 5), rr = r & 15, cc = c & 31, ob = rr * 64 + cc * 2; return st * 1024 + (ob ^ (((ob >> 9) & 1) << 5)); }
__host__ __device__ __forceinline__ void stage_rc(int b, int& R, int& C) { const int st = b / 1024, sb = b % 1024, swz = sb ^ (((sb >> 9) & 1) << 5); R = (st >> 1) * 16 + swz / 64; C = (st & 1) * 32 + (swz % 64) / 2; }
__host__ __device__ __forceinline__ int perm32(int rho) { const int n = rho >> 4, i = rho & 15; return 8 * (i >> 2) + 4 * n + (i & 3); }

struct Unit { int pm, pn; };
struct Gemm { const bf16_t* A; const bf16_t* Bt; int M, N, K; };

struct StaticOrder {
    int nM, nN, nwg, G, c;
    __host__ __device__ void init(int M, int N, int G_, int c_) { nM = M / BM; nN = N / BM; nwg = nM * nN; G = G_; c = c_; }
    __host__ __device__ bool next(int i, Unit& u) const {
        const long L = (long)i * G + c; if (L >= nwg) return false;
        int wgid = (int)L; { const int q = nwg / NXCD, r = nwg % NXCD, xcd = wgid % NXCD, off = wgid / NXCD; wgid = (xcd < r ? xcd * (q + 1) : r * (q + 1) + (xcd - r) * q) + off; }
        const int nig = WGM * nN, gid = wgid / nig, fm = gid * WGM, gsz = (nM - fm) < WGM ? (nM - fm) : WGM;
        u.pm = fm + ((wgid % nig) % gsz); u.pn = (wgid % nig) / gsz; return true;
    }
    __device__ __forceinline__ void a_ready(const Unit&) const {}
    __device__ __forceinline__ void done(const Unit&) const {}
};

__device__ __forceinline__ unsigned cvt_pk_bf16(float lo, float hi) { unsigned r; asm volatile("v_cvt_pk_bf16_f32 %0, %1, %2" : "=v"(r) : "v"(lo), "v"(hi)); return r; }
template <class Epi, class Sched, bool ALIGN_EPI = false, bool SP2 = false>
__device__ __forceinline__ void gemm_phase(PG8_LAS unsigned char* lds, const Gemm g, const Sched& S, const Epi& E, const int tid) {
    const int wid = __builtin_amdgcn_readfirstlane(tid >> 6), lane = tid & 63, wr = wid >> 2, wc = wid & 3, fr = lane & 15, fq = lane >> 4;
    const int K = g.K, nt = K / BK;
    unsigned voffA[2], voffB[2];
#pragma unroll
    for (int i = 0; i < 2; ++i) { int R, C; stage_rc(tid * 16 + i * 8192, R, C); const int Rb = Epi::PERM ? ((R & ~31) + perm32(R & 31)) : R;
        voffA[i] = (unsigned)(R * K + C) * 2u; voffB[i] = (unsigned)(Rb * K + C) * 2u; }
    const size_t kstep = (size_t)(BK * 2);
    const size_t hstep = (size_t)HALF * K * 2;
    const size_t tstep = 2 * hstep;
    const unsigned ldsw = (unsigned)wid * 1024u;
    const int aoff = lds_byte(wr * 64 + fr, fq * 8), boff = lds_byte(wc * 32 + fr, fq * 8);
#define PG8_SA(b, h) (((b) * 2 + (h)) * HTB)
#define PG8_SB(b, h) ((4 + (b) * 2 + (h)) * HTB)
#define PG8_STAGE(bufoff, gbase, voff) do { _Pragma("unroll") for (int _i = 0; _i < 2; ++_i) \
        __builtin_amdgcn_global_load_lds((const unsigned*)((const char*)(gbase) + (voff)[_i]), (PG8_LAS unsigned*)(lds + (bufoff) + ldsw + _i * 8192), 16, 0, 0); } while (0)
#define PG8_LDA(dst, b, h) do { _Pragma("unroll") for (int m = 0; m < 4; ++m) _Pragma("unroll") for (int k = 0; k < 2; ++k) dst[m][k] = *(const PG8_LAS bf16x8*)(lds + PG8_SA(b, h) + aoff + m * 2048 + k * 1024); } while (0)
#define PG8_LDB(dst, b, h) do { _Pragma("unroll") for (int n = 0; n < 2; ++n) _Pragma("unroll") for (int k = 0; k < 2; ++k) dst[n][k] = *(const PG8_LAS bf16x8*)(lds + PG8_SB(b, h) + boff + n * 2048 + k * 1024); } while (0)
#define PG8_MMA(ai, bj, At, Bt) do { __builtin_amdgcn_s_setprio(1); _Pragma("unroll") for (int m = 0; m < 4; ++m) _Pragma("unroll") for (int n = 0; n < 2; ++n) _Pragma("unroll") for (int k = 0; k < 2; ++k) \
        acc[ai][bj][m][n] = __builtin_amdgcn_mfma_f32_16x16x32_bf16(Bt[n][k], At[m][k], acc[ai][bj][m][n], 0, 0, 0); __builtin_amdgcn_s_setprio(0); } while (0)
#define PG8_WAIT_V(n) asm volatile("s_waitcnt vmcnt(" #n ")" ::: "memory")
#define PG8_WAIT_L(n) asm volatile("s_waitcnt lgkmcnt(" #n ")" ::: "memory")
#define PG8_BAR __builtin_amdgcn_s_barrier()
#define PG8_SCHED __builtin_amdgcn_sched_barrier(0)
    Unit cur, nxt; int ui = 0;
    if (!S.next(0, cur)) return;
    f32x4 acc[2][2][4][2];
#pragma unroll
    for (int a = 0; a < 2; ++a)
#pragma unroll
        for (int b = 0; b < 2; ++b)
#pragma unroll
            for (int m = 0; m < 4; ++m)
#pragma unroll
                for (int n = 0; n < 2; ++n) acc[a][b][m][n] = (f32x4){0.f, 0.f, 0.f, 0.f};
    bf16x8 At[4][2], B0[2][2], B1[2][2];
    const char* cA = (const char*)g.A + (size_t)cur.pm * tstep; const char* cB = (const char*)g.Bt + (size_t)cur.pn * tstep;
    S.a_ready(cur);
    if constexpr (SP2) {
        PG8_STAGE(PG8_SB(0, 0), cB, voffB); PG8_STAGE(PG8_SB(0, 1), cB + hstep, voffB); PG8_STAGE(PG8_SA(0, 0), cA, voffA); PG8_STAGE(PG8_SA(0, 1), cA + hstep, voffA);
        if (wr == 1) PG8_BAR;
        PG8_WAIT_V(2); PG8_BAR;
        PG8_STAGE(PG8_SB(1, 0), cB + kstep, voffB); PG8_STAGE(PG8_SA(1, 0), cA + kstep, voffA); PG8_STAGE(PG8_SB(1, 1), cB + hstep + kstep, voffB);
        PG8_WAIT_V(6); PG8_BAR;
    } else {
        PG8_STAGE(PG8_SB(0, 0), cB, voffB); PG8_STAGE(PG8_SA(0, 0), cA, voffA); PG8_STAGE(PG8_SB(0, 1), cB + hstep, voffB); PG8_STAGE(PG8_SA(0, 1), cA + hstep, voffA);
        if (wr == 1) PG8_BAR;
        PG8_WAIT_V(4); PG8_BAR;
        PG8_STAGE(PG8_SB(1, 0), cB + kstep, voffB); PG8_STAGE(PG8_SA(1, 0), cA + kstep, voffA); PG8_STAGE(PG8_SB(1, 1), cB + hstep + kstep, voffB);
        PG8_WAIT_V(6); PG8_BAR;
    }
    for (;;) {
        const bool has_next = S.next(ui + 1, nxt);
        const char* nA = has_next ? (const char*)g.A + (size_t)nxt.pm * tstep : cA; const char* nB = has_next ? (const char*)g.Bt + (size_t)nxt.pn * tstep : cB;
        for (int t = 0; t < nt; t += 2) {
            const bool last = (t == nt - 2);
            const char* a1 = cA + (size_t)(t + 1) * kstep;
            const char* a2 = last ? nA : cA + (size_t)(t + 2) * kstep; const char* b2 = last ? nB : cB + (size_t)(t + 2) * kstep;
            const char* a3 = a2 + kstep; const char* b3 = b2 + kstep;
            if (last && has_next) S.a_ready(nxt);
            if constexpr (SP2) {
            PG8_LDB(B0, 0, 0); PG8_LDB(B1, 0, 1); PG8_SCHED; PG8_LDA(At, 0, 0); PG8_STAGE(PG8_SA(1, 1), a1 + hstep, voffA);
            PG8_WAIT_V(8); PG8_WAIT_L(0); PG8_BAR; PG8_MMA(0, 0, At, B0); PG8_MMA(0, 1, At, B1); PG8_BAR; PG8_SCHED;
            PG8_LDA(At, 0, 1); PG8_STAGE(PG8_SB(0, 0), b2, voffB); PG8_STAGE(PG8_SB(0, 1), b2 + hstep, voffB); PG8_STAGE(PG8_SA(0, 0), a2, voffA);
            PG8_WAIT_V(8); PG8_WAIT_L(0); PG8_BAR; PG8_MMA(1, 0, At, B0); PG8_MMA(1, 1, At, B1); PG8_BAR; PG8_SCHED;
            PG8_LDB(B0, 1, 0); PG8_LDB(B1, 1, 1); PG8_SCHED; PG8_LDA(At, 1, 0); PG8_STAGE(PG8_SA(0, 1), a2 + hstep, voffA);
            PG8_WAIT_V(8); PG8_WAIT_L(0); PG8_BAR; PG8_MMA(0, 0, At, B0); PG8_MMA(0, 1, At, B1); PG8_BAR; PG8_SCHED;
            PG8_LDA(At, 1, 1); PG8_STAGE(PG8_SB(1, 0), b3, voffB); PG8_STAGE(PG8_SB(1, 1), b3 + hstep, voffB); PG8_STAGE(PG8_SA(1, 0), a3, voffA);
            PG8_WAIT_V(8); PG8_WAIT_L(0); PG8_BAR; PG8_MMA(1, 0, At, B0); PG8_MMA(1, 1, At, B1); PG8_BAR; PG8_SCHED;
            } else {
            PG8_LDB(B0, 0, 0); PG8_SCHED; PG8_LDA(At, 0, 0); PG8_STAGE(PG8_SA(1, 1), a1 + hstep, voffA);
            PG8_WAIT_L(8); PG8_BAR; PG8_WAIT_L(0); PG8_MMA(0, 0, At, B0); PG8_BAR; PG8_SCHED;
            PG8_LDB(B1, 0, 1); PG8_STAGE(PG8_SB(0, 0), b2, voffB);
            PG8_BAR; PG8_WAIT_L(0); PG8_MMA(0, 1, At, B1); PG8_BAR;
            PG8_LDA(At, 0, 1); PG8_STAGE(PG8_SA(0, 0), a2, voffA);
            PG8_BAR; PG8_WAIT_L(0); PG8_MMA(1, 0, At, B0); PG8_BAR; PG8_SCHED;
            PG8_STAGE(PG8_SB(0, 1), b2 + hstep, voffB);
            PG8_WAIT_V(6); PG8_BAR; PG8_MMA(1, 1, At, B1); PG8_BAR;
            PG8_LDB(B0, 1, 0); PG8_SCHED; PG8_LDA(At, 1, 0); PG8_STAGE(PG8_SA(0, 1), a2 + hstep, voffA);
            PG8_WAIT_L(8); PG8_BAR; PG8_WAIT_L(0); PG8_MMA(0, 0, At, B0); PG8_BAR; PG8_SCHED;
            PG8_LDB(B1, 1, 1); PG8_STAGE(PG8_SB(1, 0), b3, voffB);
            PG8_BAR; PG8_WAIT_L(0); PG8_MMA(0, 1, At, B1); PG8_BAR;
            PG8_LDA(At, 1, 1); PG8_STAGE(PG8_SA(1, 0), a3, voffA);
            PG8_BAR; PG8_WAIT_L(0); PG8_MMA(1, 0, At, B0); PG8_BAR; PG8_SCHED;
            PG8_STAGE(PG8_SB(1, 1), b3 + hstep, voffB);
            PG8_WAIT_V(6); PG8_BAR; PG8_MMA(1, 1, At, B1); PG8_BAR;
            }
        }
        if constexpr (ALIGN_EPI) { if (wr == 0) PG8_BAR; }
        if constexpr (!Epi::AFTER_DRAIN) { E(acc, cur, wr, wc, fr, fq); S.done(cur); }
        if (!has_next) break;
#pragma unroll
        for (int a = 0; a < 2; ++a)
#pragma unroll
            for (int b = 0; b < 2; ++b)
#pragma unroll
                for (int m = 0; m < 4; ++m)
#pragma unroll
                    for (int n = 0; n < 2; ++n) acc[a][b][m][n] = (f32x4){0.f, 0.f, 0.f, 0.f};
        cur = nxt; cA = nA; cB = nB; ++ui;
        if constexpr (ALIGN_EPI) { if (wr == 1) PG8_BAR; }
    }
    PG8_WAIT_V(0);
    if constexpr (!ALIGN_EPI) { if (wr == 0) PG8_BAR; }
    PG8_BAR;
    if constexpr (Epi::AFTER_DRAIN) { E.fused(acc, cur, wr, wc, fr, fq, lds, wid, lane); S.done(cur); }
#undef PG8_SA
#undef PG8_SB
#undef PG8_STAGE
#undef PG8_LDA
#undef PG8_LDB
#undef PG8_MMA
#undef PG8_WAIT_V
#undef PG8_WAIT_L
#undef PG8_BAR
#undef PG8_SCHED
}
}
#ifndef REP_MASK
#define REP_MASK 0
#endif
#ifndef REP_N
#define REP_N 3
#endif
#ifndef SYNC_N
#define SYNC_N 1
#endif
#ifndef PG8_SP2
#define PG8_SP2 true
#endif
#ifndef PG8_ALIGN
#define PG8_ALIGN true
#endif
#define LAS __attribute__((address_space(3)))
typedef unsigned short bf16;
typedef short bf16x8 __attribute__((ext_vector_type(8)));
typedef short s16x4 __attribute__((ext_vector_type(4)));
typedef float f32x4 __attribute__((ext_vector_type(4)));
typedef float f32x16 __attribute__((ext_vector_type(16)));
typedef unsigned u32x4 __attribute__((ext_vector_type(4)));
typedef unsigned u32x2 __attribute__((ext_vector_type(2)));

constexpr int BATCH = 4, SEQ = 8192, DM = 1024, DEPTH = 2, NHD = 8, DFF = 4096;
constexpr int M = BATCH * SEQ;
constexpr int NIN = 3584, LDP = 3584;
constexpr int NCH = SEQ / 64;
constexpr float EPS = 1e-6f;
constexpr int PC_MQ = 0, PC_MK = 512, PC_MV = 1024, PC_MO = 1536, PC_SQ = 2048, PC_SK = 2560, PC_SV = 3072;
constexpr size_t MiB = 1u << 20;
constexpr size_t WS_SSQ = 0, WS_SC = 512 * 1024, WS_W = 1 * MiB, W_LAYER = 25 * MiB + MiB / 2;
constexpr size_t WO_IN = 0, WO_OUT = 7 * MiB + MiB / 2, WO_UP = 9 * MiB + MiB / 2, WO_DN = 17 * MiB + MiB / 2;
constexpr size_t WS_XB = 52 * MiB, WS_Y = 116 * MiB, WS_P = 180 * MiB, WS_CST = 408 * MiB, WS_H = 180 * MiB, WS_GATE = 473 * MiB, WS_END = 475 * MiB;
constexpr size_t WO_G = 7 * MiB;
constexpr int CST_STRIDE = 4096;
constexpr size_t WS_NST = WS_CST + 40 * MiB;
constexpr int WAVE_LDS = 19712, LDS_BAR_OFF = 8 * WAVE_LDS, LDS_BYTES = LDS_BAR_OFF + 64;
constexpr size_t WS_BAR = 576 * 1024;
constexpr int RS = 144;
static_assert(LDS_BYTES >= pg8::STAGE_BYTES, "lds");

__device__ __forceinline__ float bf2f(unsigned short x) { return __uint_as_float((unsigned)x << 16); }
typedef float f32x2_t __attribute__((ext_vector_type(2))); typedef __bf16 bf16x2_t __attribute__((ext_vector_type(2)));
__device__ __forceinline__ unsigned pk2v(float lo, float hi) { const f32x2_t v = {lo, hi}; const bf16x2_t r = __builtin_convertvector(v, bf16x2_t); return __builtin_bit_cast(unsigned, r); }
__device__ __forceinline__ unsigned pk2(float lo, float hi) { return pg8::cvt_pk_bf16(lo, hi); }
typedef short v4i16_t __attribute__((ext_vector_type(4)));
__device__ __forceinline__ s16x4 tr4(LAS const unsigned char* p) { return __builtin_bit_cast(s16x4, __builtin_amdgcn_ds_read_tr16_b64_v4i16((LAS v4i16_t*)p)); }
__device__ __forceinline__ bf16x8 trfrag16(LAS const unsigned char* T, int rb_lo, int rb_hi, int col, int lane) {
    const int q4 = (lane & 15) >> 2, p = lane & 3;
    const s16x4 lo = tr4(T + (rb_lo + q4) * RS + (col + 4 * p) * 2), hi = tr4(T + (rb_hi + q4) * RS + (col + 4 * p) * 2);
    return (bf16x8){lo[0], lo[1], lo[2], lo[3], hi[0], hi[1], hi[2], hi[3]};
}
__device__ __forceinline__ bf16x8 trfrag32(LAS const unsigned char* T, int rb_lo, int rb_hi, int col32, int lane) {
    const int q4 = (lane & 15) >> 2, p = lane & 3, blk = (lane >> 4) & 1;
    const s16x4 lo = tr4(T + (rb_lo + q4) * RS + (col32 + 16 * blk + 4 * p) * 2), hi = tr4(T + (rb_hi + q4) * RS + (col32 + 16 * blk + 4 * p) * 2);
    return (bf16x8){lo[0], lo[1], lo[2], lo[3], hi[0], hi[1], hi[2], hi[3]};
}
__device__ __forceinline__ float wave_incl_sum(float v, int lane) {
#pragma unroll
    for (int o = 1; o < 64; o <<= 1) { const float t = __shfl_up(v, o); if (lane >= o) v += t; }
    return v;
}
__device__ __forceinline__ float wave_incl_max(float v, int lane) {
#pragma unroll
    for (int o = 1; o < 64; o <<= 1) { const float t = __shfl_up(v, o); if (lane >= o) v = fmaxf(v, t); }
    return v;
}
__device__ __forceinline__ float wave_max(float v) {
#pragma unroll
    for (int o = 1; o < 64; o <<= 1) v = fmaxf(v, __shfl_xor(v, o));
    return v;
}
__device__ __forceinline__ float wave_sum(float v) {
#pragma unroll
    for (int o = 1; o < 64; o <<= 1) v += __shfl_xor(v, o);
    return v;
}

struct EpiP {
    static constexpr bool PERM = true, AFTER_DRAIN = false;
    bf16* O; const float* ssq;
    __device__ __forceinline__ void operator()(const pg8::f32x4 (&acc)[2][2][4][2], const pg8::Unit& u, int wr, int wc, int fr, int fq) const {
        const int row0 = u.pm * 256 + wr * 64 + fr, col0 = u.pn * 256 + wc * 32 + 8 * fq;
        float rr[2][4];
#pragma unroll
        for (int ai = 0; ai < 2; ++ai)
#pragma unroll
            for (int m = 0; m < 4; ++m) rr[ai][m] = ssq[row0 + ai * 128 + m * 16];
#pragma unroll
        for (int ai = 0; ai < 2; ++ai)
#pragma unroll
            for (int m = 0; m < 4; ++m) {
                const int row = row0 + ai * 128 + m * 16; const float r = rsqrtf(rr[ai][m] * (1.0f / DM) + EPS);
                bf16* rowp = O + (size_t)row * LDP + col0;
#pragma unroll
                for (int bj = 0; bj < 2; ++bj) {
                    const pg8::f32x4 v0 = acc[ai][bj][m][0] * r, v1 = acc[ai][bj][m][1] * r;
                    u32x4 w; w.x = pk2(v0[0], v0[1]); w.y = pk2(v0[2], v0[3]); w.z = pk2(v1[0], v1[1]); w.w = pk2(v1[2], v1[3]);
                    *(u32x4*)(rowp + bj * 128) = w; }
            }
    }
};
struct EpiUp {
    static constexpr bool PERM = true, AFTER_DRAIN = false;
    bf16* O; const float* ssq;
    __device__ __forceinline__ void operator()(const pg8::f32x4 (&acc)[2][2][4][2], const pg8::Unit& u, int wr, int wc, int fr, int fq) const {
        const int row0 = u.pm * 256 + wr * 64 + fr, col0 = u.pn * 256 + wc * 32 + 8 * fq;
        float rr[2][4];
#pragma unroll
        for (int ai = 0; ai < 2; ++ai)
#pragma unroll
            for (int m = 0; m < 4; ++m) rr[ai][m] = ssq[row0 + ai * 128 + m * 16];
#pragma unroll
        for (int ai = 0; ai < 2; ++ai)
#pragma unroll
            for (int m = 0; m < 4; ++m) {
                const int row = row0 + ai * 128 + m * 16; const float r = rsqrtf(rr[ai][m] * (1.0f / DM) + EPS);
                bf16* rowp = O + (size_t)row * DFF + col0;
#pragma unroll
                for (int bj = 0; bj < 2; ++bj) {
                    pg8::f32x4 v0 = acc[ai][bj][m][0] * r, v1 = acc[ai][bj][m][1] * r;
#pragma unroll
                    for (int e = 0; e < 4; ++e) { v0[e] = fmaxf(v0[e], 0.f); v0[e] *= v0[e]; v1[e] = fmaxf(v1[e], 0.f); v1[e] *= v1[e]; }
                    u32x4 w; w.x = pk2(v0[0], v0[1]); w.y = pk2(v0[2], v0[3]); w.z = pk2(v1[0], v1[1]); w.w = pk2(v1[2], v1[3]);
                    *(u32x4*)(rowp + bj * 128) = w; }
            }
    }
};
struct EpiRes {
    static constexpr bool PERM = true, AFTER_DRAIN = false;
    const float* base32; bf16* xb; float* out32; float* ssq;
    __device__ __forceinline__ void operator()(const pg8::f32x4 (&acc)[2][2][4][2], const pg8::Unit& u, int wr, int wc, int fr, int fq) const {
        const int row0 = u.pm * 256 + wr * 64 + fr, col0 = u.pn * 256 + wc * 32 + 8 * fq;
#pragma unroll
        for (int ai = 0; ai < 2; ++ai) {
            pg8::f32x4 bv[4][2][2];
#pragma unroll
            for (int m = 0; m < 4; ++m) { const size_t off = (size_t)(row0 + ai * 128 + m * 16) * DM + col0;
                if (base32) {
#pragma unroll
                    for (int bj = 0; bj < 2; ++bj)
#pragma unroll
                        for (int n = 0; n < 2; ++n) bv[m][bj][n] = *(const pg8::f32x4*)(base32 + off + bj * 128 + n * 4);
                } else {
#pragma unroll
                    for (int bj = 0; bj < 2; ++bj) { const u32x4 w = *(const u32x4*)(xb + off + bj * 128);
                        bv[m][bj][0] = (pg8::f32x4){__uint_as_float(w.x << 16), __uint_as_float(w.x & 0xffff0000u), __uint_as_float(w.y << 16), __uint_as_float(w.y & 0xffff0000u)};
                        bv[m][bj][1] = (pg8::f32x4){__uint_as_float(w.z << 16), __uint_as_float(w.z & 0xffff0000u), __uint_as_float(w.w << 16), __uint_as_float(w.w & 0xffff0000u)}; }
                } }
            asm volatile("" ::: "memory");
#pragma unroll
            for (int m = 0; m < 4; ++m) {
                const int row = row0 + ai * 128 + m * 16; const size_t off = (size_t)row * DM + col0; float s = 0.f;
#pragma unroll
                for (int bj = 0; bj < 2; ++bj) {
                    const size_t o2 = off + bj * 128;
                    const pg8::f32x4 o0 = bv[m][bj][0] + acc[ai][bj][m][0], o1 = bv[m][bj][1] + acc[ai][bj][m][1];
                    s += ((o0[0] * o0[0] + o0[1] * o0[1]) + (o0[2] * o0[2] + o0[3] * o0[3])) + ((o1[0] * o1[0] + o1[1] * o1[1]) + (o1[2] * o1[2] + o1[3] * o1[3]));
                    if (out32) { *(pg8::f32x4*)(out32 + o2) = o0; *(pg8::f32x4*)(out32 + o2 + 4) = o1; }
                    else { u32x4 w; w.x = pk2(o0[0], o0[1]); w.y = pk2(o0[2], o0[3]); w.z = pk2(o1[0], o1[1]); w.w = pk2(o1[2], o1[3]); *(u32x4*)(xb + o2) = w; }
                }
                if (ssq) { s += __shfl_xor(s, 16); s += __shfl_xor(s, 32); if (fq == 0) atomicAdd(ssq + row, s); }
            }
        }
    }
};

struct Ctx {
    const float *x, *attn_g, *w_in, *conv_w, *conv_b, *b_i, *b_f, *qn_g, *kn_g, *on_g, *w_out, *mlp_g, *w_up, *w_dn;
    float* out; unsigned char* ws;
    float* ssq; float* sc; bf16 *XB, *Y, *P, *H; bf16* CST; float* NST; float* GATES;
    int G, wg, wave, lane, tid;
};

__device__ __forceinline__ int in_src(int n) { return n < 2048 ? n : n + 16; }
template <bool REMAP>
__device__ __forceinline__ void tr_item(const float* W, int K, int Nsrc, int Ndst, bf16* WT, const float* g, LAS float* scr, int item, int lane) {
    const int nblk = Ndst / 32, kb = item / nblk, nb = item % nblk, k0 = 64 * kb, n0 = 32 * nb;
    const int n = n0 + (lane & 31); const int src = REMAP ? in_src(n) : n;
    float vv[32];
#pragma unroll
    for (int i = 0; i < 32; ++i) { const int kk = 2 * i + (lane >> 5); vv[i] = (src >= 0) ? W[(size_t)(k0 + kk) * Nsrc + src] : 0.f; }
#pragma unroll
    for (int i = 0; i < 32; ++i) { const int kk = 2 * i + (lane >> 5); float v = vv[i]; if (g) v *= g[k0 + kk]; scr[kk * 33 + (lane & 31)] = v; }
    const int c = lane & 7;
#pragma unroll
    for (int j = 0; j < 4; ++j) { const int nn = (lane >> 3) + 8 * j; const LAS float* s = scr + (8 * c) * 33 + nn;
        u32x4 o; o.x = pk2(s[0 * 33], s[1 * 33]); o.y = pk2(s[2 * 33], s[3 * 33]); o.z = pk2(s[4 * 33], s[5 * 33]); o.w = pk2(s[6 * 33], s[7 * 33]);
        *(u32x4*)(WT + (size_t)(n0 + nn) * K + k0 + 8 * c) = o; }
}
__device__ __forceinline__ void weight_items(const Ctx& X, LAS unsigned char* wl, int l, int gwi, int ngwi) {
    LAS float* scr = (LAS float*)wl; const int lane = X.lane;
    constexpr int I_IN = 16 * (NIN / 32), I_OUT = 16 * 32, I_UP = 16 * (DFF / 32), I_DN = 64 * 32, I_L = I_IN + I_OUT + I_UP + I_DN;
    unsigned char* wb = X.ws + WS_W + (size_t)l * W_LAYER;
    for (int it = gwi; it < I_L; it += ngwi) {
        int r = it;
        if (r < I_IN) { tr_item<true>(X.w_in + (size_t)l * DM * 3600, DM, 3600, NIN, (bf16*)(wb + WO_IN), X.attn_g + l * DM, scr, r, lane); continue; } r -= I_IN;
        if (r < I_OUT) { tr_item<false>(X.w_out + (size_t)l * DM * DM, DM, DM, DM, (bf16*)(wb + WO_OUT), nullptr, scr, r, lane); continue; } r -= I_OUT;
        if (r < I_UP) { tr_item<false>(X.w_up + (size_t)l * DM * DFF, DM, DFF, DFF, (bf16*)(wb + WO_UP), X.mlp_g + l * DM, scr, r, lane); continue; } r -= I_UP;
        tr_item<false>(X.w_dn + (size_t)l * DFF * DM, DFF, DM, DM, (bf16*)(wb + WO_DN), nullptr, scr, r, lane);
    }
}
__device__ __forceinline__ void prologue(const Ctx& X, LAS unsigned char* wl) {
    const int gw = X.wg * 8 + X.wave, NGW = X.G * 8, lane = X.lane;
    weight_items(X, wl, 0, gw, NGW);
    for (int i = gw * 64 + lane; i < DEPTH * 16 * DM; i += NGW * 64) { const int l = i / (16 * DM), n = (i / DM) & 15, k = i & (DM - 1);
        ((bf16*)(X.ws + WS_W + (size_t)l * W_LAYER + WO_G))[n * DM + k] = (bf16)(pk2(X.w_in[((size_t)l * DM + k) * 3600 + 2048 + n] * X.attn_g[l * DM + k], 0.f) & 0xffffu); }
    for (int m0 = gw * 4; m0 < M; m0 += NGW * 4) {
        f32x4 v[4][4];
#pragma unroll
        for (int r = 0; r < 4; ++r)
#pragma unroll
            for (int j = 0; j < 4; ++j) v[r][j] = ((const f32x4*)(X.x + (size_t)(m0 + r) * DM) + lane)[64 * j];
#pragma unroll
        for (int r = 0; r < 4; ++r) { float s = 0.f; unsigned long long* o8 = (unsigned long long*)(X.XB + (size_t)(m0 + r) * DM) + lane;
#pragma unroll
            for (int j = 0; j < 4; ++j) { const f32x4 t = v[r][j]; s += (t[0] * t[0] + t[1] * t[1]) + (t[2] * t[2] + t[3] * t[3]);
                o8[64 * j] = (unsigned long long)pk2(t[0], t[1]) | ((unsigned long long)pk2(t[2], t[3]) << 32); }
            s = wave_sum(s);
            if (lane == 0) { const int m = m0 + r; X.ssq[m] = s; X.ssq[M + m] = 0.f; X.ssq[2 * M + m] = 0.f; X.ssq[3 * M + m] = 0.f; } }
    }
}

__device__ __forceinline__ void gates_rows(const Ctx& X, int l, const float* ssq) {
    const int lane = X.lane, fr = lane & 15, g = lane >> 4, gw = X.wg * 8 + X.wave, NGW = X.G * 8;
    const bf16* Wg = (const bf16*)(X.ws + WS_W + (size_t)l * W_LAYER + WO_G) + (size_t)fr * DM + 8 * g;
    for (int t = gw; t < M / 16; t += NGW) {
        const bf16* A = X.XB + (size_t)(16 * t + fr) * DM + 8 * g;
        f32x4 acc = (f32x4){0.f, 0.f, 0.f, 0.f};
#pragma unroll 8
        for (int ks = 0; ks < 32; ++ks) { const bf16x8 a = *(const bf16x8*)(A + 32 * ks), w = *(const bf16x8*)(Wg + 32 * ks); acc = __builtin_amdgcn_mfma_f32_16x16x32_bf16(w, a, acc, 0, 0, 0); }
        const int row = 16 * t + fr; const float r = rsqrtf(ssq[row] * (1.0f / DM) + EPS);
        acc *= r;
        *(f32x4*)(X.GATES + (size_t)row * 16 + 4 * g) = acc;
    }
}

struct ConvW { float w[4][8]; float b[8]; };
__device__ __forceinline__ void load_convw(ConvW& c, const float* conv_w, const float* conv_b, int ch) {
#pragma unroll
    for (int j = 0; j < 4; ++j) { const f32x4 a = *(const f32x4*)(conv_w + j * 1024 + ch), b = *(const f32x4*)(conv_w + j * 1024 + ch + 4);
        c.w[j][0] = a[0]; c.w[j][1] = a[1]; c.w[j][2] = a[2]; c.w[j][3] = a[3]; c.w[j][4] = b[0]; c.w[j][5] = b[1]; c.w[j][6] = b[2]; c.w[j][7] = b[3]; }
    const f32x4 a = *(const f32x4*)(conv_b + ch), b = *(const f32x4*)(conv_b + ch + 4);
    c.b[0] = a[0]; c.b[1] = a[1]; c.b[2] = a[2]; c.b[3] = a[3]; c.b[4] = b[0]; c.b[5] = b[1]; c.b[6] = b[2]; c.b[7] = b[3];
}
__device__ __forceinline__ void conv_silu8(float (&v)[8], const ConvW& c, const bf16* Pb, int tpos, int pc) {
#pragma unroll
    for (int i = 0; i < 8; ++i) v[i] = c.b[i];
#pragma unroll
    for (int j = 0; j < 4; ++j) { const int tt = tpos - 3 + j;
        if (tt >= 0) { const bf16x8 u = *(const bf16x8*)(Pb + (size_t)tt * LDP + pc);
#pragma unroll
            for (int i = 0; i < 8; ++i) v[i] += bf2f((unsigned short)u[i]) * c.w[j][i]; } }
#pragma unroll
    for (int i = 0; i < 8; ++i) v[i] = v[i] * __builtin_amdgcn_rcpf(1.0f + __expf(-v[i]));
}
__device__ __forceinline__ bf16x8 pack8(const float (&v)[8]) {
    u32x4 w; w.x = pk2(v[0], v[1]); w.y = pk2(v[2], v[3]); w.z = pk2(v[4], v[5]); w.w = pk2(v[6], v[7]); return __builtin_bit_cast(bf16x8, w);
}
__device__ __forceinline__ float log_sigmoid(float x) { return fminf(x, 0.f) - __logf(1.0f + __expf(-fabsf(x))); }
#define MFMA16(a, b, c) __builtin_amdgcn_mfma_f32_16x16x32_bf16((a), (b), (c), 0, 0, 0)
#define MFMA32(a, b, c) __builtin_amdgcn_mfma_f32_32x32x16_bf16((a), (b), (c), 0, 0, 0)

__device__ __forceinline__ void conv_rows8(float (&o)[8], const ConvW& c, const bf16x8 (&raw)[11], int r) {
#pragma unroll
    for (int i = 0; i < 8; ++i) o[i] = c.b[i];
#pragma unroll
    for (int j = 0; j < 4; ++j)
#pragma unroll
        for (int i = 0; i < 8; ++i) o[i] = __builtin_fmaf(bf2f((unsigned short)raw[r + j][i]), c.w[j][i], o[i]);
#pragma unroll
    for (int i = 0; i < 8; ++i) o[i] = o[i] * __builtin_amdgcn_rcpf(1.0f + __expf(-o[i]));
}
__device__ __forceinline__ void mlstm_local(const Ctx& X, int l, int bh, int c, LAS unsigned char* wl) {
    const int lane = X.lane, g = lane >> 4, b = bh >> 3, h = bh & 7, oct = lane & 7, rg = lane >> 3;
    const bf16* Pb = X.P + (size_t)b * SEQ * LDP; const int t0 = c * 64;
    bf16* QKb = (bf16*)X.out + ((size_t)b * SEQ + t0) * DM;
    LAS unsigned char* KW = wl; LAS unsigned char* Vt = wl + 64 * RS; LAS float* wsm = (LAS float*)(wl + 2 * 64 * RS);
    bf16x8 rq[11], rk[11]; u32x4 vv[8];
    const float* grow = X.GATES + ((size_t)b * SEQ + t0 + lane) * 16;
    const float gi = grow[h], gf = grow[8 + h];
#pragma unroll
    for (int i = 0; i < 11; ++i) { const int tt = t0 + 8 * rg - 3 + i;
        if (tt >= 0) { rq[i] = *(const bf16x8*)(Pb + (size_t)tt * LDP + PC_MQ + 64 * h + 8 * oct); rk[i] = *(const bf16x8*)(Pb + (size_t)tt * LDP + PC_MK + 64 * h + 8 * oct); }
        else { rq[i] = (bf16x8){0, 0, 0, 0, 0, 0, 0, 0}; rk[i] = (bf16x8){0, 0, 0, 0, 0, 0, 0, 0}; } }
#pragma unroll
    for (int i = 0; i < 8; ++i) vv[i] = *(const u32x4*)(Pb + (size_t)(t0 + 8 * i + rg) * LDP + PC_MV + 64 * h + oct * 8);
    ConvW cwq; load_convw(cwq, X.conv_w + (size_t)l * 4096, X.conv_b + (size_t)l * 1024, 64 * h + 8 * oct);
    {   const float ip = gi + X.b_i[l * NHD + h], fp = gf + X.b_f[l * NHD + h];
        const float bc = wave_incl_sum(log_sigmoid(fp), lane), a = ip - bc, amax = wave_max(a);
        wsm[lane] = __expf(a - amax);
        const float blast = __shfl(bc, 63);
        if (lane == 0) { float* sc = X.sc + (size_t)(bh * NCH + c) * 4; sc[0] = blast; sc[1] = blast + amax; }
    }
#pragma unroll
    for (int i = 0; i < 8; ++i) *(LAS u32x4*)(Vt + (8 * i + rg) * RS + oct * 16) = vv[i];
    {   const ConvW& cw = cwq;
#pragma unroll
        for (int r = 0; r < 8; ++r) { float o[8]; conv_rows8(o, cw, rq, r);
#pragma unroll
            for (int i = 0; i < 8; ++i) o[i] *= 0.125f;
            *(bf16x8*)(QKb + (size_t)(8 * rg + r) * DM + 64 * h + 8 * oct) = pack8(o); } }
    {   ConvW cw; load_convw(cw, X.conv_w + (size_t)l * 4096, X.conv_b + (size_t)l * 1024, 512 + 64 * h + 8 * oct);
        const f32x4 w0 = *(const LAS f32x4*)(wsm + 8 * rg), w1 = *(const LAS f32x4*)(wsm + 8 * rg + 4);
#pragma unroll
        for (int r = 0; r < 8; ++r) { float o[8]; conv_rows8(o, cw, rk, r);
            *(bf16x8*)(QKb + (size_t)(8 * rg + r) * DM + 512 + 64 * h + 8 * oct) = pack8(o);
            const float w = r < 4 ? w0[r & 3] : w1[r & 3];
#pragma unroll
            for (int i = 0; i < 8; ++i) o[i] *= w;
            *(LAS bf16x8*)(KW + (8 * rg + r) * RS + oct * 16) = pack8(o); } }
    const bf16x8 ones = (lane & 15) == 0 ? (bf16x8){0x3F80, 0x3F80, 0x3F80, 0x3F80, 0x3F80, 0x3F80, 0x3F80, 0x3F80} : (bf16x8){0, 0, 0, 0, 0, 0, 0, 0};
    bf16* cst = X.CST + (size_t)(bh * NCH + c) * CST_STRIDE; float* nst = X.NST + (size_t)(bh * NCH + c) * 64;
#pragma unroll 1
    for (int kt = 0; kt < 4; ++kt) {
        f32x4 acc[5];
#pragma unroll
        for (int i = 0; i < 5; ++i) acc[i] = (f32x4){0.f, 0.f, 0.f, 0.f};
#pragma unroll
        for (int ks = 0; ks < 2; ++ks) {
            const bf16x8 bfr = trfrag16(KW, 32 * ks + 8 * g, 32 * ks + 8 * g + 4, 16 * kt, lane);
#pragma unroll
            for (int vt = 0; vt < 4; ++vt) { const bf16x8 afr = trfrag16(Vt, 32 * ks + 8 * g, 32 * ks + 8 * g + 4, 16 * vt, lane); acc[vt] = MFMA16(afr, bfr, acc[vt]); }
            acc[4] = MFMA16(ones, bfr, acc[4]);
        }
        bf16* dst = cst + (16 * kt + (lane & 15)) * 64;
#pragma unroll
        for (int vt = 0; vt < 4; ++vt) { u32x2 w; w.x = pk2v(acc[vt][0], acc[vt][1]); w.y = pk2v(acc[vt][2], acc[vt][3]); *(u32x2*)(dst + 16 * vt + 4 * g) = w; }
        if (g == 0) nst[16 * kt + (lane & 15)] = acc[4][0];
    }
}

__device__ __forceinline__ void mlstm_scan(const Ctx& X) {
    for (int u = X.wg; u < 32 * 4; u += X.G) {
        const int bh = u >> 2, sl = u & 3; const int e2 = sl * 512 + X.tid; const bool extra = (sl == 0 && X.tid < 64);
        unsigned* base = (unsigned*)(X.CST + (size_t)bh * NCH * CST_STRIDE); float* nbase = X.NST + (size_t)bh * NCH * 64; float* sc = X.sc + (size_t)bh * NCH * 4;
        float m = 0.f, C0 = 0.f, C1 = 0.f, Cn = 0.f;
#pragma unroll 1
        for (int cb = 0; cb < NCH; cb += 16) {
            unsigned cl[16]; float cn[16], bl[16], ml[16];
#pragma unroll
            for (int i = 0; i < 16; ++i) { cl[i] = base[(size_t)(cb + i) * (CST_STRIDE / 2) + e2]; cn[i] = extra ? nbase[(cb + i) * 64 + X.tid] : 0.f; bl[i] = sc[(cb + i) * 4 + 0]; ml[i] = sc[(cb + i) * 4 + 1]; }
#pragma unroll
            for (int i = 0; i < 16; ++i) {
                base[(size_t)(cb + i) * (CST_STRIDE / 2) + e2] = pk2(C0, C1); if (extra) nbase[(cb + i) * 64 + X.tid] = Cn;
                if (e2 == 0) sc[(cb + i) * 4 + 2] = m;
                const float mn = fmaxf(bl[i] + m, ml[i]), dec = __expf(bl[i] + m - mn), wl = __expf(ml[i] - mn);
                C0 = dec * C0 + wl * __uint_as_float(cl[i] << 16); C1 = dec * C1 + wl * __uint_as_float(cl[i] & 0xffff0000u); Cn = dec * Cn + wl * cn[i]; m = mn; }
        }
    }
}

__device__ __forceinline__ void mlstm_out(const Ctx& X, int l, int bh, int c, LAS unsigned char* wl) {
    const int lane = X.lane, g = lane >> 4, fr = lane & 15, b = bh >> 3, h = bh & 7;
    const bf16* Pb = X.P + (size_t)b * SEQ * LDP; const int t0 = c * 64;
    LAS unsigned char* Ct = wl; LAS unsigned char* Vt = wl + 64 * RS;
    LAS float* f_as = (LAS float*)(wl + 2 * 64 * RS); LAS float* f_M = f_as + 64; LAS float* f_si = f_as + 128; LAS float* f_en = f_as + 192;
    LAS unsigned short* nb = (LAS unsigned short*)(f_as + 256);
    const bf16* cst = X.CST + (size_t)(bh * NCH + c) * CST_STRIDE; const float* nst = X.NST + (size_t)(bh * NCH + c) * 64;
    u32x4 cstv[8], vv[8];
#pragma unroll
    for (int i = 0; i < 8; ++i) { const int row = 8 * i + (lane >> 3), ch = lane & 7;
        cstv[i] = *(const u32x4*)(cst + row * 64 + ch * 8); vv[i] = *(const u32x4*)(Pb + (size_t)(t0 + row) * LDP + PC_MV + 64 * h + ch * 8); }
    bf16x8 qf[4][2], kf[4][2];
    {   const bf16* QKb = (const bf16*)X.out + ((size_t)b * SEQ + t0) * DM + 64 * h + 8 * g;
#pragma unroll
        for (int j = 0; j < 4; ++j)
#pragma unroll
            for (int ks = 0; ks < 2; ++ks) { qf[j][ks] = *(const bf16x8*)(QKb + (size_t)(16 * j + fr) * DM + 32 * ks); kf[j][ks] = *(const bf16x8*)(QKb + (size_t)(16 * j + fr) * DM + 512 + 32 * ks); } }
    {   const float* grow = X.GATES + ((size_t)b * SEQ + t0 + lane) * 16;
        const float mprev = X.sc[(size_t)(bh * NCH + c) * 4 + 2];
        const float ip = grow[h] + X.b_i[l * NHD + h], fp = grow[8 + h] + X.b_f[l * NHD + h];
        const float bc = wave_incl_sum(log_sigmoid(fp), lane), a = ip - bc;
        const float Mt = fmaxf(mprev, wave_incl_max(a, lane));
        f_as[lane] = a; f_M[lane] = Mt; f_si[lane] = __expf(mprev - Mt); f_en[lane] = __expf(-(bc + Mt));
        nb[lane] = (unsigned short)(pk2(nst[lane], 0.f) & 0xffffu);
    }
#pragma unroll
    for (int i = 0; i < 8; ++i) { const int row = 8 * i + (lane >> 3), ch = lane & 7;
        *(LAS u32x4*)(Ct + row * RS + ch * 16) = cstv[i]; *(LAS u32x4*)(Vt + row * RS + ch * 16) = vv[i]; }
    const bf16x8 ones = fr == 0 ? (bf16x8){0x3F80, 0x3F80, 0x3F80, 0x3F80, 0x3F80, 0x3F80, 0x3F80, 0x3F80} : (bf16x8){0, 0, 0, 0, 0, 0, 0, 0};
    bf16x8 nfr[2];
#pragma unroll
    for (int ks = 0; ks < 2; ++ks) { const bf16x8 t = *(const LAS bf16x8*)(nb + 32 * ks + 8 * g); nfr[ks] = fr == 0 ? t : (bf16x8){0, 0, 0, 0, 0, 0, 0, 0}; }
    const float* og = X.on_g + (size_t)l * DM + 64 * h;
    u32x2 ogate[4][4]; f32x4 gain[4];
#pragma unroll
    for (int vt = 0; vt < 4; ++vt) { gain[vt] = *(const f32x4*)(og + 16 * vt + 4 * g);
#pragma unroll
        for (int j = 0; j < 4; ++j) ogate[j][vt] = *(const u32x2*)(Pb + (size_t)(t0 + 16 * j + fr) * LDP + PC_MO + 64 * h + 16 * vt + 4 * g); }
#pragma unroll
    for (int j = 0; j < 4; ++j) {
        const int t = 16 * j + fr;
        f32x4 acc[5];
#pragma unroll
        for (int i = 0; i < 5; ++i) acc[i] = (f32x4){0.f, 0.f, 0.f, 0.f};
#pragma unroll
        for (int ks = 0; ks < 2; ++ks) {
#pragma unroll
            for (int vt = 0; vt < 4; ++vt) { const bf16x8 afr = trfrag16(Ct, 32 * ks + 8 * g, 32 * ks + 8 * g + 4, 16 * vt, lane); acc[vt] = MFMA16(afr, qf[j][ks], acc[vt]); }
            acc[4] = MFMA16(nfr[ks], qf[j][ks], acc[4]);
        }
        const float si = f_si[t], Mt = f_M[t];
#pragma unroll
        for (int i = 0; i < 5; ++i) acc[i] *= si;
        f32x4 st[4];
#pragma unroll
        for (int sblk = 0; sblk < 4; ++sblk) {
            st[sblk] = (f32x4){0.f, 0.f, 0.f, 0.f};
            if (sblk <= j) {
                st[sblk] = MFMA16(kf[sblk][0], qf[j][0], st[sblk]); st[sblk] = MFMA16(kf[sblk][1], qf[j][1], st[sblk]);
                const f32x4 av = *(const LAS f32x4*)(f_as + 16 * sblk + 4 * g);
#pragma unroll
                for (int e = 0; e < 4; ++e) { const int s = 16 * sblk + 4 * g + e; const float w = (s <= t) ? __expf(av[e] - Mt) : 0.f; st[sblk][e] *= w; }
            }
        }
#pragma unroll
        for (int u = 0; u < 2; ++u) {
            if (2 * u <= j) {
                u32x4 w; w.x = pk2(st[2 * u][0], st[2 * u][1]); w.y = pk2(st[2 * u][2], st[2 * u][3]); w.z = pk2(st[2 * u + 1][0], st[2 * u + 1][1]); w.w = pk2(st[2 * u + 1][2], st[2 * u + 1][3]);
                const bf16x8 wf = __builtin_bit_cast(bf16x8, w);
#pragma unroll
                for (int vt = 0; vt < 4; ++vt) { const bf16x8 afr = trfrag16(Vt, 32 * u + 4 * g, 32 * u + 16 + 4 * g, 16 * vt, lane); acc[vt] = MFMA16(afr, wf, acc[vt]); }
                acc[4] = MFMA16(ones, wf, acc[4]);
            }
        }
        const float den = __shfl(acc[4][0], fr);
        const float inv = __builtin_amdgcn_rcpf(fmaxf(fabsf(den), f_en[t]));
        float ss = 0.f;
#pragma unroll
        for (int vt = 0; vt < 4; ++vt) { acc[vt] *= inv; ss += (acc[vt][0] * acc[vt][0] + acc[vt][1] * acc[vt][1]) + (acc[vt][2] * acc[vt][2] + acc[vt][3] * acc[vt][3]); }
        ss += __shfl_xor(ss, 16); ss += __shfl_xor(ss, 32);
        const float rn = rsqrtf(ss * (1.0f / 64.0f) + EPS);
        bf16* yrow = X.Y + ((size_t)b * SEQ + t0 + t) * DM + 64 * h;
#pragma unroll
        for (int vt = 0; vt < 4; ++vt) { const int v0 = 16 * vt + 4 * g;
            const u32x2 ob = ogate[j][vt]; const f32x4 gg = gain[vt];
            float o[4] = {__uint_as_float(ob.x << 16), __uint_as_float(ob.x & 0xffff0000u), __uint_as_float(ob.y << 16), __uint_as_float(ob.y & 0xffff0000u)};
            float r[4];
#pragma unroll
            for (int e = 0; e < 4; ++e) r[e] = acc[vt][e] * rn * gg[e] * __builtin_amdgcn_rcpf(1.0f + __expf(-o[e]));
            u32x2 w; w.x = pk2(r[0], r[1]); w.y = pk2(r[2], r[3]); *(u32x2*)(yrow + v0) = w; }
    }
}

__device__ __forceinline__ float half_sum(float v) { const auto rr = __builtin_amdgcn_permlane32_swap(__float_as_uint(v), __float_as_uint(v), false, false); return __uint_as_float(rr[0]) + __uint_as_float(rr[1]); }
__device__ __forceinline__ float half_other(float v, int hi) { const auto rr = __builtin_amdgcn_permlane32_swap(__float_as_uint(v), __float_as_uint(v), false, false); return hi ? __uint_as_float(rr[0]) : __uint_as_float(rr[1]); }
__device__ __forceinline__ void norm_frag(bf16x8 (&f)[4], const bf16x8 (&raw)[4], const float* gain, float scale, int hi) {
    float v[4][8]; float ss = 0.f;
#pragma unroll
    for (int ds = 0; ds < 4; ++ds)
#pragma unroll
        for (int i = 0; i < 8; ++i) { v[ds][i] = bf2f((unsigned short)raw[ds][i]); ss += v[ds][i] * v[ds][i]; }
    ss = half_sum(ss);
    const float r = rsqrtf(ss * (1.0f / 64.0f) + EPS) * scale;
#pragma unroll
    for (int ds = 0; ds < 4; ++ds) { const f32x4 g0 = *(const f32x4*)(gain + 16 * ds + 8 * hi), g1 = *(const f32x4*)(gain + 16 * ds + 8 * hi + 4);
        float w[8];
#pragma unroll
        for (int i = 0; i < 4; ++i) { w[i] = v[ds][i] * r * g0[i]; w[4 + i] = v[ds][4 + i] * r * g1[i]; }
        f[ds] = pack8(w); }
}
__device__ __forceinline__ void knorm_frag(bf16x8 (&f)[4], const bf16x8 (&raw)[4]) {
    float v[4][8]; float ss = 0.f;
#pragma unroll
    for (int ds = 0; ds < 4; ++ds)
#pragma unroll
        for (int i = 0; i < 8; ++i) { v[ds][i] = bf2f((unsigned short)raw[ds][i]); ss = __builtin_fmaf(v[ds][i], v[ds][i], ss); }
    ss = half_sum(ss);
    const float r = rsqrtf(ss * (1.0f / 64.0f) + EPS);
#pragma unroll
    for (int ds = 0; ds < 4; ++ds) { float w[8];
#pragma unroll
        for (int i = 0; i < 8; ++i) w[i] = v[ds][i] * r;
        f[ds] = pack8(w); }
}
constexpr int SB_ROWS = 416, SB_VS_OFF = SB_ROWS * RS, SB_FB_OFF = 2 * SB_ROWS * RS, SB_FB_BYTES = 32 * RS;
constexpr int SB_GQK_OFF = SB_FB_OFF + 8 * SB_FB_BYTES, SB_OG_OFF = SB_GQK_OFF + 256;
static_assert(SB_OG_OFF + 256 <= LDS_BAR_OFF, "SB LDS map");
__device__ __forceinline__ void sb_phase(const Ctx& X, int l, LAS unsigned char* lds) {
    const int lane = X.lane, q = lane & 31, hi = lane >> 5, wave = X.wave, tid = X.tid;
    LAS unsigned char* Ks = lds; LAS unsigned char* Vs = lds + SB_VS_OFF; LAS unsigned char* Vfb = lds + SB_FB_OFF + wave * SB_FB_BYTES;
    const int rsub = tid >> 3, ch = tid & 7;
    bf16x8 skr[7]; u32x4 svr[7];
#define SB_STAGE_LOAD(u_) do { const int bh_ = (u_) >> 5, ub_ = (u_) & 31; const bf16* Pb_ = X.P + (size_t)(bh_ >> 3) * SEQ * LDP + 64 * (bh_ & 7) + ch * 8; \
        _Pragma("unroll") for (int i = 0; i < 7; ++i) { const int srow = rsub + 64 * i, grow = 256 * ub_ - 160 + srow; \
            if (srow < SB_ROWS && grow >= 0) { skr[i] = *(const bf16x8*)(Pb_ + (size_t)grow * LDP + PC_SK); svr[i] = *(const u32x4*)(Pb_ + (size_t)grow * LDP + PC_SV); } \
            else { skr[i] = (bf16x8){0, 0, 0, 0, 0, 0, 0, 0}; svr[i] = (u32x4){0u, 0u, 0u, 0u}; } } } while (0)
    int u = X.wg;
    if (u < 32 * 32) SB_STAGE_LOAD(u);
    for (; u < 32 * 32; u += X.G) {
        const int bh = u >> 5, ub = u & 31, b = bh >> 3, h = bh & 7, qb = 8 * ub + wave;
        const bf16* Pb = X.P + (size_t)b * SEQ * LDP;
        bf16x8 qraw[4];
        {   const bf16* rowp = Pb + (size_t)(32 * qb + q) * LDP + PC_SQ + 64 * h + 8 * hi;
#pragma unroll
            for (int ds = 0; ds < 4; ++ds) qraw[ds] = *(const bf16x8*)(rowp + 16 * ds); }
        float gtab = 0.f;
        if (tid < 64) gtab = X.on_g[(size_t)l * DM + 512 + 64 * h + tid];
        else if (tid < 128) gtab = X.qn_g[l * 64 + tid - 64] * X.kn_g[l * 64 + tid - 64] * (0.125f * 1.4426950408889634f);
#pragma unroll
        for (int i = 0; i < 7; ++i) { const int srow = rsub + 64 * i;
            float v[8]; float ss = 0.f;
#pragma unroll
            for (int e = 0; e < 8; ++e) { v[e] = bf2f((unsigned short)skr[i][e]); ss = __builtin_fmaf(v[e], v[e], ss); }
            ss += __shfl_xor(ss, 1); ss += __shfl_xor(ss, 2); ss += __shfl_xor(ss, 4);
            const float r = rsqrtf(ss * (1.0f / 64.0f) + EPS);
#pragma unroll
            for (int e = 0; e < 8; ++e) v[e] *= r;
            if (srow < SB_ROWS) { *(LAS bf16x8*)(Ks + srow * RS + ch * 16) = pack8(v); *(LAS u32x4*)(Vs + srow * RS + ch * 16) = svr[i]; } }
        if (tid < 64) ((LAS float*)(lds + SB_OG_OFF))[tid] = gtab; else if (tid < 128) ((LAS float*)(lds + SB_GQK_OFF))[tid - 64] = gtab;
        __syncthreads();
        if (u + X.G < 32 * 32) SB_STAGE_LOAD(u + X.G);
        bf16x8 qf[4];
        {   float v[4][8]; float ss = 0.f;
#pragma unroll
            for (int ds = 0; ds < 4; ++ds)
#pragma unroll
                for (int i = 0; i < 8; ++i) { v[ds][i] = bf2f((unsigned short)qraw[ds][i]); ss = __builtin_fmaf(v[ds][i], v[ds][i], ss); }
            ss = half_sum(ss);
            const float r = rsqrtf(ss * (1.0f / 64.0f) + EPS);
            const LAS float* gqk = (const LAS float*)(lds + SB_GQK_OFF) + 8 * hi;
#pragma unroll
            for (int ds = 0; ds < 4; ++ds) { const f32x4 a0 = *(const LAS f32x4*)(gqk + 16 * ds), a1 = *(const LAS f32x4*)(gqk + 16 * ds + 4);
                float w[8];
#pragma unroll
                for (int i = 0; i < 4; ++i) { w[i] = v[ds][i] * r * a0[i]; w[4 + i] = v[ds][4 + i] * r * a1[i]; }
                qf[ds] = pack8(w); } }
        f32x16 o0, o1;
#pragma unroll
        for (int r = 0; r < 16; ++r) { o0[r] = 0.f; o1[r] = 0.f; }
        float Pm = 1.0f;
#define SB_CORE(KF, VT, DIAG) do { \
        f32x16 s; \
        _Pragma("unroll") for (int r = 0; r < 16; ++r) s[r] = 0.f; \
        _Pragma("unroll") for (int ds = 0; ds < 4; ++ds) s = MFMA32(KF[ds], qf[ds], s); \
        const bool diag = (DIAG); \
        float fct[16], bet[16];     \
        _Pragma("unroll") for (int r = 0; r < 16; ++r) { const int key = (r & 3) + 8 * (r >> 2) + 4 * hi; \
            const float e = __builtin_amdgcn_exp2f(s[r]); const float rc = __builtin_amdgcn_rcpf(1.0f + e); const bool msk = diag && key >= q; \
            fct[r] = msk ? 1.0f : rc; bet[r] = msk ? 0.f : e * rc; } \
        float T[4], To[4], Pg[4]; \
        _Pragma("unroll") for (int G = 0; G < 4; ++G) { T[G] = (fct[4 * G] * fct[4 * G + 1]) * (fct[4 * G + 2] * fct[4 * G + 3]); To[G] = half_other(T[G], hi); Pg[G] = T[G] * To[G]; } \
        float later[4]; later[3] = 1.0f; later[2] = Pg[3]; later[1] = Pg[3] * Pg[2]; later[0] = later[1] * Pg[1]; \
        float a[16]; \
        _Pragma("unroll") for (int G = 0; G < 4; ++G) { float run = (Pm * later[G]) * (hi == 0 ? To[G] : 1.0f); \
            _Pragma("unroll") for (int e = 3; e >= 0; --e) { const int r = 4 * G + e; a[r] = bet[r] * run; run *= fct[r]; } } \
        Pm *= later[0] * Pg[0]; \
        bf16x8 pf[2]; \
        _Pragma("unroll") for (int kk = 0; kk < 2; ++kk) { u32x4 w; w.x = pk2(a[8 * kk], a[8 * kk + 1]); w.y = pk2(a[8 * kk + 2], a[8 * kk + 3]); w.z = pk2(a[8 * kk + 4], a[8 * kk + 5]); w.w = pk2(a[8 * kk + 6], a[8 * kk + 7]); pf[kk] = __builtin_bit_cast(bf16x8, w); } \
        _Pragma("unroll") for (int kk = 0; kk < 2; ++kk) { \
            const bf16x8 v0 = trfrag32((VT), 16 * kk + 4 * hi, 16 * kk + 8 + 4 * hi, 0, lane), v1 = trfrag32((VT), 16 * kk + 4 * hi, 16 * kk + 8 + 4 * hi, 32, lane); \
            o0 = MFMA32(v0, pf[kk], o0); o1 = MFMA32(v1, pf[kk], o1); } \
    } while (0)
        bool done = false;
        const int tl_min = (8 * ub - 5 >= 0) ? 0 : 5 - 8 * ub;
        for (int Tl = wave + 5; Tl >= tl_min; --Tl) {
            bf16x8 kf[4];
#pragma unroll
            for (int ds = 0; ds < 4; ++ds) kf[ds] = *(const LAS bf16x8*)(Ks + (32 * Tl + q) * RS + (16 * ds + 8 * hi) * 2);
            SB_CORE(kf, Vs + 32 * Tl * RS, Tl == wave + 5);
            if (__all(Pm < 1.17549435e-38f)) { done = true; break; }
        }
        if (!done && 8 * ub - 6 >= 0) {
            const bf16* kbase = Pb + PC_SK + 64 * h + 8 * hi + (size_t)q * LDP;
            const bf16* vbase = Pb + PC_SV + 64 * h + (lane & 7) * 8 + (size_t)(lane >> 3) * LDP;
            for (int kt = 8 * ub - 6; kt >= 0; --kt) {
                bf16x8 kr[4], kf[4]; u32x4 vr[4];
                const bf16* krow_ = kbase + (size_t)(32 * kt) * LDP; const bf16* vrow_ = vbase + (size_t)(32 * kt) * LDP;
#pragma unroll
                for (int ds = 0; ds < 4; ++ds) kr[ds] = *(const bf16x8*)(krow_ + 16 * ds);
#pragma unroll
                for (int i = 0; i < 4; ++i) vr[i] = *(const u32x4*)(vrow_ + (size_t)(8 * i) * LDP);
                knorm_frag(kf, kr);
#pragma unroll
                for (int i = 0; i < 4; ++i) *(LAS u32x4*)(Vfb + (8 * i + (lane >> 3)) * RS + (lane & 7) * 16) = vr[i];
                SB_CORE(kf, Vfb, false);
                if (__all(Pm < 1.17549435e-38f)) break;
            }
        }
#undef SB_CORE
        {   float ss = 0.f;
#pragma unroll
            for (int r = 0; r < 16; ++r) ss += o0[r] * o0[r] + o1[r] * o1[r];
            ss = half_sum(ss);
            const float rn = rsqrtf(ss * (1.0f / 64.0f) + EPS);
            const LAS float* og = (const LAS float*)(lds + SB_OG_OFF);
#pragma unroll
            for (int G = 0; G < 4; ++G) {
                const int d0 = 8 * G + 4 * hi; const f32x4 g0 = *(const LAS f32x4*)(og + d0), g1 = *(const LAS f32x4*)(og + 32 + d0);
                u32x2 w0, w1;
                w0.x = pk2(o0[4 * G] * rn * g0[0], o0[4 * G + 1] * rn * g0[1]); w0.y = pk2(o0[4 * G + 2] * rn * g0[2], o0[4 * G + 3] * rn * g0[3]);
                w1.x = pk2(o1[4 * G] * rn * g1[0], o1[4 * G + 1] * rn * g1[1]); w1.y = pk2(o1[4 * G + 2] * rn * g1[2], o1[4 * G + 3] * rn * g1[3]);
                *(LAS u32x2*)(Vfb + q * RS + d0 * 2) = w0; *(LAS u32x2*)(Vfb + q * RS + (32 + d0) * 2) = w1; }
            bf16* ybase = X.Y + ((size_t)b * SEQ + 32 * qb) * DM + 512 + 64 * h + (lane & 7) * 8;
#pragma unroll
            for (int i = 0; i < 4; ++i) { const int row = 8 * i + (lane >> 3); const u32x4 v = *(const LAS u32x4*)(Vfb + row * RS + (lane & 7) * 16); *(u32x4*)(ybase + (size_t)row * DM) = v; } }
        __syncthreads();
    }
#undef SB_STAGE_LOAD
}

#define XB_TMO      128
#define XB_XCNT(j)  (256  + 64 * (j))
#define XB_XSUB(j)  (1280 + 64 * (j))
#define XB_XGEN(j)  (2304 + 64 * (j))
#define XB_TOP      3328
#define XB_TOPGEN   3392
#define XCD_BAR_WORDS 3456
#define XB_SPIN_CAP (1u << 18)

__device__ __forceinline__ unsigned xb_ld(unsigned* p)              { return __hip_atomic_load(p, __ATOMIC_RELAXED, __HIP_MEMORY_SCOPE_AGENT); }
__device__ __forceinline__ unsigned xb_add(unsigned* p, unsigned v) { return __hip_atomic_fetch_add(p, v, __ATOMIC_RELAXED, __HIP_MEMORY_SCOPE_AGENT); }
__device__ __forceinline__ unsigned xb_xcc_id() { return (unsigned)__builtin_amdgcn_s_getreg((3 << 11) | 20) & 0xFu; }
#define XB_SPIN(cond, bar) do { unsigned _sp = 0; while (cond) { __builtin_amdgcn_s_sleep(1); \
    if ((++_sp & 255u) == 0u) { if (xb_ld(&(bar)[XB_TMO])) break; if (_sp > XB_SPIN_CAP) { atomicAdd(&(bar)[XB_TMO], 1u); break; } } } } while (0)

struct XcdBarrier {
    unsigned* bar; unsigned x;
    volatile LAS unsigned* st;
};

__device__ __forceinline__ XcdBarrier xcd_barrier_post(unsigned* bar, volatile LAS unsigned* st) {
    XcdBarrier b; b.bar = bar; b.x = xb_xcc_id(); b.st = st;
    if (threadIdx.x == 0) (void)xb_add(&bar[XB_XCNT(b.x)], 1u);
    return b;
}
__device__ __forceinline__ void xcd_barrier_complete(unsigned* bar, unsigned x, unsigned& nloc, unsigned& nx) {
    const unsigned G = gridDim.x * gridDim.y * gridDim.z;
    unsigned sum, cnt, mine, sp = 0u;
    for (;;) {
        sum = 0u; cnt = 0u; mine = 0u;
#pragma unroll
        for (unsigned j = 0; j < 16; ++j) { const unsigned c = xb_ld(&bar[XB_XCNT(j)]); sum += c; cnt += (c > 0u) ? 1u : 0u; mine = (j == x) ? c : mine; }
        if (sum == G) break;
        __builtin_amdgcn_s_sleep(1);
        if ((++sp & 255u) == 0u) { if (xb_ld(&bar[XB_TMO])) break; if (sp > XB_SPIN_CAP) { atomicAdd(&bar[XB_TMO], 1u); break; } }
    }
    nloc = mine > 0u ? mine : 1u; nx = cnt > 0u ? cnt : 1u;
}

__device__ __forceinline__ void xcd_barrier(const XcdBarrier& b) {
    asm volatile("s_waitcnt vmcnt(0)" ::: "memory");
    __syncthreads();
    if (threadIdx.x == 0) {
        unsigned* bar = b.bar;
        __builtin_amdgcn_s_waitcnt(0);
        unsigned nloc = b.st[0], nx = b.st[1];
        if (nloc == 0u) { xcd_barrier_complete(bar, b.x, nloc, nx); b.st[0] = nloc; b.st[1] = nx; }
        const unsigned old = xb_add(&bar[XB_XSUB(b.x)], 1u);
        const unsigned gen = old / nloc;
        if (old + 1u == (gen + 1u) * nloc) {
            __builtin_amdgcn_fence(__ATOMIC_RELEASE, "agent");
            asm volatile("s_waitcnt vmcnt(0)" ::: "memory");
            const unsigned og = xb_add(&bar[XB_TOP], 1u);
            const unsigned tg = og / nx;
            if (og + 1u == (tg + 1u) * nx) xb_add(&bar[XB_TOPGEN], 1u);
            else XB_SPIN(xb_ld(&bar[XB_TOPGEN]) == tg, bar);
            __builtin_amdgcn_fence(__ATOMIC_ACQUIRE, "agent");
            xb_add(&bar[XB_XGEN(b.x)], 1u);
            asm volatile("s_waitcnt vmcnt(0)" ::: "memory");
        } else {
            XB_SPIN(xb_ld(&bar[XB_XGEN(b.x)]) == gen, bar);
            __builtin_amdgcn_fence(__ATOMIC_ACQUIRE, "agent");
            asm volatile("s_waitcnt vmcnt(0)" ::: "memory");
        }
    }
    __syncthreads();
}


struct Args { const float* in[14]; float* out; unsigned char* ws; int ph_lo, ph_hi, coop, pad; };
constexpr int N_PHASES = 1 + 7 * DEPTH;
typedef const __attribute__((address_space(4))) Args* KArgs;
__device__ __forceinline__ void build_ctx(Ctx& X, KArgs ap) {
    X.x = ap->in[0]; X.attn_g = ap->in[1]; X.w_in = ap->in[2]; X.conv_w = ap->in[3]; X.conv_b = ap->in[4]; X.b_i = ap->in[5]; X.b_f = ap->in[6]; X.qn_g = ap->in[7]; X.kn_g = ap->in[8];
    X.on_g = ap->in[9]; X.w_out = ap->in[10]; X.mlp_g = ap->in[11]; X.w_up = ap->in[12]; X.w_dn = ap->in[13];
    X.out = ap->out; unsigned char* ws = ap->ws; X.ws = ws;
    X.ssq = (float*)(ws + WS_SSQ); X.sc = (float*)(ws + WS_SC); X.XB = (bf16*)(ws + WS_XB); X.Y = (bf16*)(ws + WS_Y); X.P = (bf16*)(ws + WS_P); X.H = (bf16*)(ws + WS_H);
    X.CST = (bf16*)(ws + WS_CST); X.NST = (float*)(ws + WS_NST); X.GATES = (float*)(ws + WS_GATE);
    int G = gridDim.x, wg = blockIdx.x, tid = threadIdx.x;
    asm volatile("" : "+s"(G), "+s"(wg), "+v"(tid));
    X.G = G; X.wg = wg; X.tid = tid; X.lane = tid & 63; X.wave = __builtin_amdgcn_readfirstlane(tid >> 6);
}
__global__ void __launch_bounds__(512, 2) mk_fwd(Args a_byvalue) {
    extern __shared__ __attribute__((aligned(16))) unsigned char lds_raw[];
    int ph, ph_hi, coop;
    if (threadIdx.x < 2) ((volatile LAS unsigned*)((LAS unsigned char*)lds_raw + LDS_BAR_OFF))[threadIdx.x] = 0u;
    __syncthreads();
    { KArgs ap0 = (KArgs)__builtin_amdgcn_kernarg_segment_ptr(); if (ap0->coop) (void)xcd_barrier_post((unsigned*)(ap0->ws + WS_BAR), (volatile LAS unsigned*)((LAS unsigned char*)lds_raw + LDS_BAR_OFF)); }
    { KArgs ap = (KArgs)__builtin_amdgcn_kernarg_segment_ptr(); ph = ap->ph_lo; ph_hi = ap->ph_hi; coop = ap->coop; }
    int rep = 0;
#pragma unroll 1
    for (; ph < ph_hi;) {
        KArgs ap = (KArgs)__builtin_amdgcn_kernarg_segment_ptr();
        asm volatile("" : "+s"(ap));
        LAS unsigned char* lds = (LAS unsigned char*)lds_raw;
        Ctx X; build_ctx(X, ap);
        LAS unsigned char* wl = lds + X.wave * WAVE_LDS;
        const int gw = X.wg * 8 + X.wave, NGW = X.G * 8;
        int nrep = 1;
        if (ph == 0) { nrep = ((REP_MASK >> 7) & 1) ? REP_N : 1; prologue(X, wl);
 }
        else {
            const int l = (ph - 1) / 7, sub = (ph - 1) % 7;
            nrep = ((REP_MASK >> sub) & 1) ? REP_N : 1;
            {
            unsigned char* wb = X.ws + WS_W + (size_t)l * W_LAYER;
            if (sub == 0) {
                pg8::Gemm g{X.XB, (const bf16*)(wb + WO_IN), M, NIN, DM}; pg8::StaticOrder S; S.init(M, NIN, X.G, X.wg);
                EpiP E{X.P, X.ssq + (size_t)(2 * l) * M};
                pg8::gemm_phase<EpiP, pg8::StaticOrder, PG8_ALIGN, PG8_SP2>(lds, g, S, E, X.tid);
                gates_rows(X, l, X.ssq + (size_t)(2 * l) * M);
            } else if (sub == 1) {
#pragma unroll 1
                for (int rr = 0; rr < ((REP_MASK & 0x100) ? REP_N : 1); ++rr) for (int it = gw; it < 32 * NCH; it += NGW) mlstm_local(X, l, it / NCH, it % NCH, wl);
                __syncthreads();
#pragma unroll 1
                for (int rr = 0; rr < ((REP_MASK & 0x200) ? REP_N : 1); ++rr) sb_phase(X, l, lds);
            } else if (sub == 2) {
                mlstm_scan(X);
                if (l + 1 < DEPTH && X.wg >= 128) weight_items(X, wl, l + 1, (X.wg - 128) * 8 + X.wave, (X.G - 128) * 8);
            } else if (sub == 3) {
                for (int it = gw; it < 32 * NCH; it += NGW) mlstm_out(X, l, it / NCH, it % NCH, wl);
            } else if (sub == 4) {
                pg8::Gemm g{X.Y, (const bf16*)(wb + WO_OUT), M, DM, DM}; pg8::StaticOrder S; S.init(M, DM, X.G, X.wg);
                EpiRes E{l == 0 ? X.x : nullptr, X.XB, nullptr, X.ssq + (size_t)(2 * l + 1) * M};
                pg8::gemm_phase<EpiRes, pg8::StaticOrder, PG8_ALIGN, PG8_SP2>(lds, g, S, E, X.tid);
            } else if (sub == 5) {
                pg8::Gemm g{X.XB, (const bf16*)(wb + WO_UP), M, DFF, DM}; pg8::StaticOrder S; S.init(M, DFF, X.G, X.wg);
                EpiUp E{X.H, X.ssq + (size_t)(2 * l + 1) * M};
                pg8::gemm_phase<EpiUp, pg8::StaticOrder, PG8_ALIGN, PG8_SP2>(lds, g, S, E, X.tid);
            } else {
                pg8::Gemm g{X.H, (const bf16*)(wb + WO_DN), M, DM, DFF}; pg8::StaticOrder S; S.init(M, DM, X.G, X.wg);
                const bool last = (l == DEPTH - 1);
                EpiRes E{nullptr, X.XB, last ? X.out : nullptr, last ? nullptr : X.ssq + (size_t)(2 * l + 2) * M};
                pg8::gemm_phase<EpiRes, pg8::StaticOrder, PG8_ALIGN, PG8_SP2>(lds, g, S, E, X.tid);
            }
            }
        }
        if (REP_MASK != 0 && ++rep < nrep) { __syncthreads(); continue; }
        rep = 0;
        if (ph + 1 < ph_hi) {
            if (!coop) __syncthreads();
            else if (coop > 1) cg::this_grid().sync();
            else { XcdBarrier xbar; xbar.bar = (unsigned*)(X.ws + WS_BAR); xbar.x = xb_xcc_id(); xbar.st = (volatile LAS unsigned*)(lds + LDS_BAR_OFF); for (int sy = 0; sy < SYNC_N; ++sy) xcd_barrier(xbar); }
        }
        ++ph;
    }
}

#ifndef MK_MULTI
#define MK_MULTI 0
#endif
extern "C" void kernel_launch(void* const* d_in, const int* in_sizes, int n_in, void* d_out, int out_size, void* d_ws, size_t ws_size, hipStream_t stream) {
    static int grid = 0;
    if (grid == 0) {
        if (n_in != 14 || out_size != M * DM || ws_size < WS_END) { fprintf(stderr, "kernel_launch: unexpected shapes (n_in %d out %d ws %zu)\n", n_in, out_size, ws_size); grid = -1; return; }
        int dev = 0, cus = 0, per_cu = 0;
        hipGetDevice(&dev); hipDeviceGetAttribute(&cus, hipDeviceAttributeMultiprocessorCount, dev);
        if (hipFuncSetAttribute((const void*)mk_fwd, hipFuncAttributeMaxDynamicSharedMemorySize, LDS_BYTES) != hipSuccess) { fprintf(stderr, "kernel_launch: hipFuncSetAttribute failed\n"); grid = -1; return; }
        if (hipOccupancyMaxActiveBlocksPerMultiprocessor(&per_cu, (const void*)mk_fwd, 512, LDS_BYTES) != hipSuccess || per_cu < 1) { fprintf(stderr, "kernel_launch: occupancy query says %d\n", per_cu); per_cu = 1; }
        (void)hipGetLastError();
        grid = cus * 1;
        fprintf(stderr, "kernel_launch: grid %d (cus %d, per_cu %d)\n", grid, cus, per_cu);
    }
    if (grid < 0) return;
    Args a{};
    for (int i = 0; i < 14; ++i) a.in[i] = (const float*)d_in[i];
    a.out = (float*)d_out; a.ws = (unsigned char*)d_ws;
#if MK_MULTI
    for (int ph = 0; ph < N_PHASES; ++ph) { a.ph_lo = ph; a.ph_hi = ph + 1; a.coop = 0; hipLaunchKernelGGL(mk_fwd, dim3(grid), dim3(512), LDS_BYTES, stream, a); }
#else
    a.ph_lo = 0; a.ph_hi = N_PHASES; a.coop = 1;
    if (hipMemsetAsync((char*)d_ws + WS_BAR, 0, XCD_BAR_WORDS * 4, stream) != hipSuccess) { fprintf(stderr, "kernel_launch: memset failed\n"); return; }
    void* args[] = {&a};
    hipError_t e = hipLaunchCooperativeKernel((const void*)mk_fwd, dim3(grid), dim3(512), args, LDS_BYTES, stream);
    if (e != hipSuccess) fprintf(stderr, "cooperative launch failed: %s (grid %d)\n", hipGetErrorString(e), grid);
#endif
}
```
